# Optimizing an MI355X kernel written in HIP

```python
import math
import jax, jax.numpy as jnp
from jax import lax
import numpy as np

D_MODEL = 2048
BATCH = 4
SEQ = 4096
DEPTH = 1

D_MIX = D_MODEL
ATTN_WIDTH = D_MIX // 2
SSM_WIDTH = D_MIX - ATTN_WIDTH
N_HEADS = 8
HEAD_DIM = ATTN_WIDTH // N_HEADS
MOBA_BLOCK = 256
MOBA_TOPK = 3
Q_CHUNK = 32
SSM_GROUP = 16
N_SSM_GROUPS = SSM_WIDTH // SSM_GROUP
SSM_STATE = 64
DT_MIN = 1e-3
DT_MAX = 1e-1
D_FF = ((8 * D_MODEL // 3 + 255) // 256) * 256
IN_PROJ_WIDTH = 3 * ATTN_WIDTH + SSM_WIDTH
N_MOD = 9
LN_EPS = 1e-5
NEG_INF = -1e30
ALPHA = (2.0 * DEPTH) ** 0.25
BETA = (8.0 * DEPTH) ** -0.25

kernel_name = 'hybrid_moba_s5_macaron_block'


def _layer_norm(y, g, b):
    y32 = y.astype(jnp.float32)
    mu = jnp.mean(y32, axis=-1, keepdims=True)
    var = jnp.mean(jnp.square(y32 - mu), axis=-1, keepdims=True)
    return ((y32 - mu) * lax.rsqrt(var + LN_EPS) * g + b).astype(y.dtype)


def _rms_norm(y, g):
    y32 = y.astype(jnp.float32)
    return (y32 * lax.rsqrt(jnp.mean(jnp.square(y32), axis=-1, keepdims=True) + LN_EPS) * g).astype(y.dtype)


def _modulate(y, shift, scale):
    return y * (1.0 + scale) + shift


def _swiglu(u, w_gate, w_up, w_down):
    return (jax.nn.silu(u @ w_gate) * (u @ w_up)) @ w_down


def _alibi_slopes(n_heads):
    return 2.0 ** (-(8.0 / n_heads) * jnp.arange(1, n_heads + 1, dtype=jnp.float32))


def _moba_attention(q, k, v):
    B, S, H, dh = q.shape
    BH = B * H

    def heads_first(t):
        return t.transpose(0, 2, 1, 3).reshape(BH, S, dh)

    q, k, v = heads_first(q), heads_first(k), heads_first(v)
    n_blocks = -(-S // MOBA_BLOCK)
    s_pad = n_blocks * MOBA_BLOCK
    pad = ((0, 0), (0, s_pad - S), (0, 0))
    k_blocks = jnp.pad(k, pad).reshape(BH, n_blocks, MOBA_BLOCK, dh)
    v_blocks = jnp.pad(v, pad).reshape(BH, n_blocks, MOBA_BLOCK, dh)

    k_mean = jnp.mean(k_blocks.astype(jnp.float32), axis=2)
    gate = jnp.einsum('nsd,njd->nsj', q.astype(jnp.float32), k_mean)
    q_block = jnp.arange(S) // MOBA_BLOCK
    fully_past = jnp.arange(n_blocks)[None, :] < q_block[:, None]
    gate = jnp.where(fully_past[None], gate, NEG_INF)
    top_k = min(MOBA_TOPK, n_blocks)
    _, sel = lax.top_k(gate, top_k)
    sel_valid = sel < q_block[None, :, None]

    slopes_n = jnp.tile(_alibi_slopes(H), B)
    scale = dh ** -0.5
    n_chunks = S // Q_CHUNK

    def to_chunks(t):
        return t.reshape((BH, n_chunks, Q_CHUNK) + t.shape[2:]).swapaxes(0, 1)

    q_c, sel_c, valid_c = to_chunks(q), to_chunks(sel), to_chunks(sel_valid)
    starts = jnp.arange(n_chunks, dtype=jnp.int32) * Q_CHUNK
    key_offs = jnp.arange(MOBA_BLOCK, dtype=jnp.int32)
    n_sel = top_k * MOBA_BLOCK

    def attend_chunk(args):
        qc, selc, validc, t0 = args
        t_pos = t0 + jnp.arange(Q_CHUNK, dtype=jnp.int32)
        own = t0 // MOBA_BLOCK
        k_own = lax.dynamic_index_in_dim(k_blocks, own, axis=1, keepdims=False)
        v_own = lax.dynamic_index_in_dim(v_blocks, own, axis=1, keepdims=False)
        k_sel = jax.vmap(lambda kb, ix: kb[ix])(k_blocks, selc)
        v_sel = jax.vmap(lambda vb, ix: vb[ix])(v_blocks, selc)
        s_sel = jnp.einsum('nqd,nqjkd->nqjk', qc, k_sel).astype(jnp.float32) * scale
        dist_sel = (t_pos[None, :, None, None] - (selc[..., None] * MOBA_BLOCK + key_offs)).astype(jnp.float32)
        s_sel = jnp.where(validc[..., None], s_sel - slopes_n[:, None, None, None] * dist_sel, NEG_INF)
        own_pos = own * MOBA_BLOCK + key_offs
        s_own = jnp.einsum('nqd,nkd->nqk', qc, k_own).astype(jnp.float32) * scale
        dist_own = (t_pos[:, None] - own_pos[None, :]).astype(jnp.float32)
        s_own = jnp.where((dist_own >= 0)[None], s_own - slopes_n[:, None, None] * dist_own, NEG_INF)
        scores = jnp.concatenate([s_sel.reshape(BH, Q_CHUNK, n_sel), s_own], axis=-1)
        p = jax.nn.softmax(scores, axis=-1).astype(v.dtype)
        return (jnp.einsum('nqk,nqkd->nqd', p[..., :n_sel], v_sel.reshape(BH, Q_CHUNK, n_sel, dh))
                + jnp.einsum('nqk,nkd->nqd', p[..., n_sel:], v_own))

    out = lax.map(attend_chunk, (q_c, sel_c, valid_c, starts))
    out = out.swapaxes(0, 1).reshape(B, H, S, dh).transpose(0, 2, 1, 3)
    return out.reshape(B, S, H * dh)


def _ssm_combine(e1, e2):
    a1r, a1i, b1r, b1i = e1
    a2r, a2i, b2r, b2i = e2
    return (a2r * a1r - a2i * a1i,
            a2r * a1i + a2i * a1r,
            a2r * b1r - a2i * b1i + b2r,
            a2r * b1i + a2i * b1r + b2i)


def _s5_layer(u, lam_re, lam_im, log_dt, b_re, b_im, c_re, c_im, d_skip, w_glu, b_glu):
    B, S, _ = u.shape
    u32 = u.astype(jnp.float32).reshape(B, S, N_SSM_GROUPS, SSM_GROUP)
    lam_re = lam_re.astype(jnp.float32)
    lam_im = lam_im.astype(jnp.float32)
    dt = jnp.exp(log_dt.astype(jnp.float32))[:, None]
    decay = jnp.exp(lam_re * dt)
    ab_re = decay * jnp.cos(lam_im * dt)
    ab_im = decay * jnp.sin(lam_im * dt)
    den = lam_re * lam_re + lam_im * lam_im
    coef_re = ((ab_re - 1.0) * lam_re + ab_im * lam_im) / den
    coef_im = (ab_im * lam_re - (ab_re - 1.0) * lam_im) / den
    b_re = b_re.astype(jnp.float32)
    b_im = b_im.astype(jnp.float32)
    bb_re = coef_re[..., None] * b_re - coef_im[..., None] * b_im
    bb_im = coef_re[..., None] * b_im + coef_im[..., None] * b_re
    bu_re = jnp.einsum('bsgh,gph->sbgp', u32, bb_re)
    bu_im = jnp.einsum('bsgh,gph->sbgp', u32, bb_im)
    a_re = jnp.broadcast_to(ab_re[None, None], (S, 1, N_SSM_GROUPS, SSM_STATE))
    a_im = jnp.broadcast_to(ab_im[None, None], (S, 1, N_SSM_GROUPS, SSM_STATE))
    _, _, x_re, x_im = lax.associative_scan(_ssm_combine, (a_re, a_im, bu_re, bu_im), axis=0)
    y = (jnp.einsum('sbgp,ghp->bsgh', x_re, c_re.astype(jnp.float32))
         - jnp.einsum('sbgp,ghp->bsgh', x_im, c_im.astype(jnp.float32)))
    y = y.reshape(B, S, SSM_WIDTH) + d_skip.astype(jnp.float32) * u32.reshape(B, S, SSM_WIDTH)
    y = jax.nn.gelu(y)
    y = y * jax.nn.sigmoid(y @ w_glu.astype(jnp.float32) + b_glu.astype(jnp.float32))
    return y.astype(u.dtype)


def setup_inputs(seed: int = 0) -> dict:
    key = jax.random.key(seed)
    ks = jax.random.split(key, 32)
    f32 = jnp.float32
    L, D, G, P, Hg = DEPTH, D_MODEL, N_SSM_GROUPS, SSM_STATE, SSM_GROUP

    def nrm(k, shape, s):
        return jax.random.normal(k, shape, f32) * s

    return {
        'x': nrm(ks[0], (BATCH, SEQ, D), 1.0),
        'c': nrm(ks[1], (BATCH, D), 1.0),
        'w_ada': nrm(ks[2], (L, D, N_MOD * D), 0.1 * D ** -0.5),
        'b_ada': nrm(ks[3], (L, N_MOD * D), 0.01),
        'ffn1_w_gate': nrm(ks[4], (L, D, D_FF), D ** -0.5),
        'ffn1_w_up': nrm(ks[5], (L, D, D_FF), D ** -0.5),
        'ffn1_w_down': nrm(ks[6], (L, D_FF, D), BETA * D_FF ** -0.5),
        'ln1_g': 1.0 + nrm(ks[7], (L, D), 0.01),
        'ln1_b': nrm(ks[8], (L, D), 0.01),
        'w_in': nrm(ks[9], (L, D, IN_PROJ_WIDTH), D ** -0.5),
        'attn_norm_g': 1.0 + nrm(ks[10], (L, ATTN_WIDTH), 0.01),
        'ssm_lambda_re': -0.5 + nrm(ks[11], (L, G, P), 0.01),
        'ssm_lambda_im': math.pi * jnp.arange(P, dtype=f32) + nrm(ks[12], (L, G, P), 0.01),
        'ssm_log_dt': jax.random.uniform(ks[13], (L, G), f32, math.log(DT_MIN), math.log(DT_MAX)),
        'ssm_b_re': nrm(ks[14], (L, G, P, Hg), (2.0 * Hg) ** -0.5),
        'ssm_b_im': nrm(ks[15], (L, G, P, Hg), (2.0 * Hg) ** -0.5),
        'ssm_c_re': nrm(ks[16], (L, G, Hg, P), (2.0 * P) ** -0.5),
        'ssm_c_im': nrm(ks[17], (L, G, Hg, P), (2.0 * P) ** -0.5),
        'ssm_d': nrm(ks[18], (L, SSM_WIDTH), 1.0),
        'ssm_w_glu': nrm(ks[19], (L, SSM_WIDTH, SSM_WIDTH), SSM_WIDTH ** -0.5),
        'ssm_b_glu': nrm(ks[20], (L, SSM_WIDTH), 0.01),
        'ssm_norm_g': 1.0 + nrm(ks[21], (L, SSM_WIDTH), 0.01),
        'w_out': nrm(ks[22], (L, D_MIX, D), BETA * D_MIX ** -0.5),
        'ln2_g': 1.0 + nrm(ks[23], (L, D), 0.01),
        'ln2_b': nrm(ks[24], (L, D), 0.01),
        'ffn2_w_gate': nrm(ks[25], (L, D, D_FF), D ** -0.5),
        'ffn2_w_up': nrm(ks[26], (L, D, D_FF), D ** -0.5),
        'ffn2_w_down': nrm(ks[27], (L, D_FF, D), BETA * D_FF ** -0.5),
        'ln3_g': 1.0 + nrm(ks[28], (L, D), 0.01),
        'ln3_b': nrm(ks[29], (L, D), 0.01),
    }


def reference(x, c, w_ada, b_ada, ffn1_w_gate, ffn1_w_up, ffn1_w_down, ln1_g, ln1_b,
              w_in, attn_norm_g, ssm_lambda_re, ssm_lambda_im, ssm_log_dt, ssm_b_re, ssm_b_im,
              ssm_c_re, ssm_c_im, ssm_d, ssm_w_glu, ssm_b_glu, ssm_norm_g, w_out, ln2_g, ln2_b,
              ffn2_w_gate, ffn2_w_up, ffn2_w_down, ln3_g, ln3_b):
    B, S, D = x.shape
    c_act = jax.nn.silu(c)
    for l in range(DEPTH):
        mod = (c_act @ w_ada[l] + b_ada[l]).reshape(B, N_MOD, D)[:, :, None, :]

        y = _swiglu(_modulate(x, mod[:, 0], mod[:, 1]), ffn1_w_gate[l], ffn1_w_up[l], ffn1_w_down[l])
        x = _layer_norm(ALPHA * x + 0.5 * (1.0 + mod[:, 2]) * y, ln1_g[l], ln1_b[l])

        h = _modulate(x, mod[:, 3], mod[:, 4]) @ w_in[l]
        q = h[..., :ATTN_WIDTH].reshape(B, S, N_HEADS, HEAD_DIM)
        k = h[..., ATTN_WIDTH:2 * ATTN_WIDTH].reshape(B, S, N_HEADS, HEAD_DIM)
        v = h[..., 2 * ATTN_WIDTH:3 * ATTN_WIDTH].reshape(B, S, N_HEADS, HEAD_DIM)
        u = h[..., 3 * ATTN_WIDTH:]
        attn_out = _rms_norm(_moba_attention(q, k, v), attn_norm_g[l])
        ssm_out = _rms_norm(_s5_layer(u, ssm_lambda_re[l], ssm_lambda_im[l], ssm_log_dt[l],
                                      ssm_b_re[l], ssm_b_im[l], ssm_c_re[l], ssm_c_im[l],
                                      ssm_d[l], ssm_w_glu[l], ssm_b_glu[l]), ssm_norm_g[l])
        mix = jnp.concatenate([attn_out, ssm_out], axis=-1) @ w_out[l]
        x = _layer_norm(ALPHA * x + (1.0 + mod[:, 5]) * mix, ln2_g[l], ln2_b[l])

        y = _swiglu(_modulate(x, mod[:, 6], mod[:, 7]), ffn2_w_gate[l], ffn2_w_up[l], ffn2_w_down[l])
        x = _layer_norm(ALPHA * x + 0.5 * (1.0 + mod[:, 8]) * y, ln3_g[l], ln3_b[l])
    return x
```

```cpp
#include <hip/hip_runtime.h>
#include <stdint.h>
#include <stdio.h>

constexpr int NB = 4, SEQ = 4096, DM = 2048, MTOK = NB * SEQ, FF = 5632, NH = 8, HD = 128, AW = 1024, SW = 1024;
constexpr int NG = 64, GP = 64, GH = 16, INW = 4096, NMOD = 9, MB = 256, NBLK = SEQ / MB, TOPK = 3;
constexpr float LN_EPS = 1e-5f, ALPHA = 1.189207115002721f, QSCALE = 0.08838834764831845f;

typedef unsigned short bf16;
__device__ __forceinline__ unsigned f2bf(float f) { unsigned u = __builtin_bit_cast(unsigned, f); return (u + 0x7fffu + ((u >> 16) & 1u)) >> 16; }
__device__ __forceinline__ float bf2f(unsigned h) { return __builtin_bit_cast(float, h << 16); }
__device__ __forceinline__ float sigmoidf_(float v) { return 1.f / (1.f + __expf(-v)); }
__device__ __forceinline__ float siluf_(float v) { return v * sigmoidf_(v); }
__device__ __forceinline__ float gelu_tanh(float v) { const float u = 0.7978845608028654f * (v + 0.044715f * v * v * v); return 0.5f * v * (1.f + tanhf(u)); }

constexpr size_t MiB = 1u << 20;
constexpr size_t WS_CTL = 0, CTL_BYTES = 2 * MiB;
constexpr size_t WS_MOD = 2 * MiB;
constexpr size_t WS_KMEAN = 3 * MiB;
constexpr size_t WS_SEL = 4 * MiB;
constexpr size_t WS_WGU1 = 6 * MiB, WS_WD1 = 50 * MiB, WS_WIN = 72 * MiB, WS_WGLU = 88 * MiB, WS_WOUT = 90 * MiB, WS_WGU2 = 98 * MiB, WS_WD2 = 142 * MiB;
constexpr size_t WS_A = 164 * MiB;
constexpr size_t WS_R = 228 * MiB;
constexpr size_t WS_H = 356 * MiB;
constexpr size_t WS_QKVU = WS_H, WS_YACT = WS_H + 128 * MiB;
constexpr size_t WS_END = 532 * MiB;
constexpr int CW_STATS1 = 65536, CW_STATS2 = CW_STATS1 + 2 * MTOK, CW_STATS3 = CW_STATS2 + 2 * MTOK, CW_SSA = CW_STATS3 + 2 * MTOK, CW_SSS = CW_SSA + MTOK;
static_assert((CW_SSS + MTOK) * 4 <= (int)CTL_BYTES, "ctl");

struct Params {
    const float* in[30]; float* out; unsigned char* ws;
};

__global__ void __launch_bounds__(256) k_mod(const float* c, const float* w, const float* bias, float* mod) {
    const int n = blockIdx.x * 256 + threadIdx.x; if (n >= NMOD * DM) return;
    float a0 = 0, a1 = 0, a2 = 0, a3 = 0;
    for (int k = 0; k < DM; ++k) { const float wv = w[(size_t)k * (NMOD * DM) + n];
        a0 += siluf_(c[k]) * wv; a1 += siluf_(c[DM + k]) * wv; a2 += siluf_(c[2 * DM + k]) * wv; a3 += siluf_(c[3 * DM + k]) * wv; }
    const float bv = bias[n]; mod[n] = a0 + bv; mod[NMOD * DM + n] = a1 + bv; mod[2 * NMOD * DM + n] = a2 + bv; mod[3 * NMOD * DM + n] = a3 + bv;
}
__global__ void __launch_bounds__(256) k_wt(const float* W0, const float* W1, bf16* Wt, int K, int N, int mode, const float* ks0, const float* ks1, int ksplit) {
    const size_t idx = (size_t)blockIdx.x * 256 + threadIdx.x; const int NR = mode ? 2 * N : N;
    if (idx >= (size_t)NR * K) return;
    const int k = (int)(idx % K), r = (int)(idx / K); float v;
    if (mode == 0) v = W0[(size_t)k * N + r];
    else { const int pn = r >> 8, j = r & 255; v = (j < 128) ? W0[(size_t)k * N + 128 * pn + j] : W1[(size_t)k * N + 128 * pn + j - 128]; }
    if (ks0) v *= (k < ksplit) ? ks0[k] : ks1[k - ksplit];
    Wt[idx] = (bf16)f2bf(v);
}
__global__ void __launch_bounds__(256) k_modulate(const float* x, const float* mod, int ishift, bf16* A) {
    const size_t idx = (size_t)blockIdx.x * 256 + threadIdx.x; if (idx >= (size_t)MTOK * DM) return;
    const int col = (int)(idx % DM), row = (int)(idx / DM), b = row / SEQ;
    const float* mb = mod + (size_t)b * NMOD * DM;
    A[idx] = (bf16)f2bf(x[idx] * (1.f + mb[(ishift + 1) * DM + col]) + mb[ishift * DM + col]);
}
__global__ void __launch_bounds__(256) k_rowstats(const float* R, float* stats) {
    __shared__ float s1[256], s2[256];
    const int row = blockIdx.x; float a = 0, q = 0;
    for (int c = threadIdx.x; c < DM; c += 256) { const float v = R[(size_t)row * DM + c]; a += v; q += v * v; }
    s1[threadIdx.x] = a; s2[threadIdx.x] = q; __syncthreads();
    for (int o = 128; o > 0; o >>= 1) { if (threadIdx.x < o) { s1[threadIdx.x] += s1[threadIdx.x + o]; s2[threadIdx.x] += s2[threadIdx.x + o]; } __syncthreads(); }
    if (threadIdx.x == 0) { stats[2 * row] = s1[0]; stats[2 * row + 1] = s2[0]; }
}
__device__ __forceinline__ void ln_coef(const float* stats, int row, float& mean, float& rstd) {
    const float s = stats[2 * row], q = stats[2 * row + 1]; mean = s * (1.f / DM); const float var = fmaxf(q * (1.f / DM) - mean * mean, 0.f); rstd = rsqrtf(var + LN_EPS);
}
__global__ void __launch_bounds__(256) k_ln_apply(const float* R, const float* stats, const float* g, const float* bta, const float* mod, int ishift, bf16* A, float* out) {
    const size_t idx = (size_t)blockIdx.x * 256 + threadIdx.x; if (idx >= (size_t)MTOK * DM) return;
    const int col = (int)(idx % DM), row = (int)(idx / DM), b = row / SEQ;
    float mean, rstd; ln_coef(stats, row, mean, rstd);
    const float v = (R[idx] - mean) * rstd * g[col] + bta[col];
    if (out) { out[idx] = v; return; }
    const float* mb = mod + (size_t)b * NMOD * DM;
    A[idx] = (bf16)f2bf(v * (1.f + mb[(ishift + 1) * DM + col]) + mb[ishift * DM + col]);
}

struct EpiSwiglu { bf16* H; __device__ void operator()(int row, int nl, float g, float u) const { H[(size_t)row * FF + nl] = (bf16)f2bf(siluf_(g) * u); } };
struct EpiStoreBf { bf16* O; int ldc; __device__ void operator()(int row, int n, float a, float) const { O[(size_t)row * ldc + n] = (bf16)f2bf(a); } };
struct EpiResid { const float* xin; float* R; const float* stats; const float* g; const float* bta; const float* mod; int igate; float gm; const float* rowmul;
    __device__ void operator()(int row, int col, float a, float) const {
        const int b = row / SEQ; const size_t idx = (size_t)row * DM + col; float xr;
        if (xin) xr = xin[idx]; else { float mean, rstd; ln_coef(stats, row, mean, rstd); xr = (R[idx] - mean) * rstd * g[col] + bta[col]; }
        if (rowmul) a *= rowmul[row];
        R[idx] = ALPHA * xr + gm * (1.f + mod[(size_t)b * NMOD * DM + igate * DM + col]) * a; } };
struct EpiGlu { const bf16* Y; const float* bias; bf16* Amix; __device__ void operator()(int row, int col, float a, float) const {
        const float ya = bf2f(Y[(size_t)row * SW + col]); Amix[(size_t)row * DM + AW + col] = (bf16)f2bf(ya * sigmoidf_(a + bias[col])); } };

template <bool DUAL, class Epi>
__global__ void __launch_bounds__(256) k_gemm(const bf16* A, const bf16* Bt, int M, int N  , int K, const float* rs0, const float* rs1, Epi E) {
    __shared__ float As[16][68], Bs[16][68], Cs[16][68];
    const int tid = threadIdx.x, tx = tid & 15, ty = tid >> 4, m0 = blockIdx.y * 64, n0 = blockIdx.x * 64;
    float acc[4][4] = {}, acc2[4][4] = {};
    const int lr = tid >> 2, lk = (tid & 3) * 4;
    const int nl = n0 + lr; const int brow = DUAL ? (256 * (nl >> 7) + (nl & 127)) : nl;
    for (int k0 = 0; k0 < K; k0 += 16) {
        { const bf16* ap = A + (size_t)(m0 + lr) * K + k0 + lk; float sc = 1.f; if (rs0) sc = (k0 < K / 2) ? rs0[m0 + lr] : rs1[m0 + lr];
          for (int i = 0; i < 4; ++i) As[lk + i][lr] = bf2f(ap[i]) * sc; }
        { const bf16* bp = Bt + (size_t)brow * K + k0 + lk; for (int i = 0; i < 4; ++i) Bs[lk + i][lr] = bf2f(bp[i]);
          if (DUAL) { const bf16* cp = bp + (size_t)128 * K; for (int i = 0; i < 4; ++i) Cs[lk + i][lr] = bf2f(cp[i]); } }
        __syncthreads();
#pragma unroll
        for (int k = 0; k < 16; ++k) {
            float a[4], b[4], c[4];
#pragma unroll
            for (int i = 0; i < 4; ++i) { a[i] = As[k][ty * 4 + i]; b[i] = Bs[k][tx * 4 + i]; c[i] = DUAL ? Cs[k][tx * 4 + i] : 0.f; }
#pragma unroll
            for (int i = 0; i < 4; ++i)
#pragma unroll
                for (int j = 0; j < 4; ++j) { acc[i][j] += a[i] * b[j]; if (DUAL) acc2[i][j] += a[i] * c[j]; }
        }
        __syncthreads();
    }
    for (int i = 0; i < 4; ++i) for (int j = 0; j < 4; ++j) E(m0 + ty * 4 + i, n0 + tx * 4 + j, acc[i][j], acc2[i][j]);
}

__global__ void __launch_bounds__(128) k_kmean(const bf16* QKVU, float* kmean) {
    const int bh = blockIdx.x / NBLK, j = blockIdx.x % NBLK, b = bh / NH, h = bh % NH, d = threadIdx.x; float s = 0;
    for (int kk = 0; kk < MB; ++kk) s += bf2f(QKVU[(size_t)(b * SEQ + j * MB + kk) * INW + AW + h * HD + d]);
    kmean[(size_t)blockIdx.x * HD + d] = s * (1.f / MB);
}
__global__ void __launch_bounds__(256) k_sel(const bf16* QKVU, const float* kmean, unsigned* sel) {
    const int idx = blockIdx.x * 256 + threadIdx.x; if (idx >= NB * NH * SEQ) return;
    const int t = idx % SEQ, bh = idx / SEQ, b = bh / NH, h = bh % NH, qb = t / MB;
    float gate[NBLK];
    const bf16* q = QKVU + (size_t)(b * SEQ + t) * INW + h * HD;
    for (int j = 0; j < NBLK; ++j) gate[j] = 0.f;
    for (int d = 0; d < HD; ++d) { const float qv = bf2f(q[d]); for (int j = 0; j < NBLK; ++j) if (j < qb) gate[j] += qv * kmean[((size_t)bh * NBLK + j) * HD + d]; }
    unsigned mask = 0;
    for (int r = 0; r < TOPK; ++r) { int best = -1; float bv = 0.f;
        for (int j = 0; j < NBLK; ++j) if (j < qb && !((mask >> j) & 1u) && (best < 0 || gate[j] > bv)) { best = j; bv = gate[j]; }
        if (best >= 0) mask |= 1u << best; }
    sel[idx] = mask;
}
__global__ void __launch_bounds__(64) k_attn(const bf16* QKVU, const unsigned* sel, bf16* Amix, float* ssa) {
    __shared__ float sq[HD], sp[4 * MB];
    const int idx = blockIdx.x, t = idx % SEQ, bh = idx / SEQ, b = bh / NH, h = bh % NH, qb = t / MB, lane = threadIdx.x;
    const float slope = exp2f(-(float)(h + 1));
    const size_t rowq = (size_t)(b * SEQ + t);
    sq[lane] = bf2f(QKVU[rowq * INW + h * HD + lane]); sq[lane + 64] = bf2f(QKVU[rowq * INW + h * HD + lane + 64]);
    __syncthreads();
    const unsigned mask = sel[idx] | (1u << qb);
    float mx = -1e30f; int ns = 0;
    for (int j = 0; j <= qb; ++j) { if (!((mask >> j) & 1u)) continue;
        for (int kk = lane; kk < MB; kk += 64) {
            const int kp = j * MB + kk; float sc = -1e30f;
            if (kp <= t) { const bf16* kr = QKVU + (size_t)(b * SEQ + kp) * INW + AW + h * HD; float a = 0;
                for (int d = 0; d < HD; ++d) a += sq[d] * bf2f(kr[d]);
                sc = a * QSCALE - slope * (float)(t - kp); }
            sp[ns * MB + kk] = sc; mx = fmaxf(mx, sc); }
        ++ns; }
    for (int o = 32; o > 0; o >>= 1) mx = fmaxf(mx, __shfl_xor(mx, o));
    float sum = 0;
    for (int i = lane; i < ns * MB; i += 64) { const float p = __expf(sp[i] - mx); sp[i] = p; sum += p; }
    for (int o = 32; o > 0; o >>= 1) sum += __shfl_xor(sum, o);
    __syncthreads();
    float o0 = 0, o1 = 0; int s = 0;
    for (int j = 0; j <= qb; ++j) { if (!((mask >> j) & 1u)) continue;
        for (int kk = 0; kk < MB; ++kk) { const int kp = j * MB + kk; if (kp > t) break;
            const float p = sp[s * MB + kk]; const bf16* vr = QKVU + (size_t)(b * SEQ + kp) * INW + 2 * AW + h * HD;
            o0 += p * bf2f(vr[lane]); o1 += p * bf2f(vr[lane + 64]); }
        ++s; }
    const float inv = 1.f / sum; o0 *= inv; o1 *= inv;
    Amix[rowq * DM + h * HD + lane] = (bf16)f2bf(o0); Amix[rowq * DM + h * HD + lane + 64] = (bf16)f2bf(o1);
    float ss = o0 * o0 + o1 * o1; for (int o = 32; o > 0; o >>= 1) ss += __shfl_xor(ss, o);
    if (lane == 0) atomicAdd(ssa + rowq, ss);
}
__global__ void __launch_bounds__(64) k_ssm(const bf16* QKVU, const float* lam_re, const float* lam_im, const float* log_dt, const float* b_re, const float* b_im,
                                            const float* c_re, const float* c_im, const float* dsk, bf16* Yact) {
    __shared__ float xs[2][GP];
    const int b = blockIdx.x / NG, g = blockIdx.x % NG, p = threadIdx.x;
    const float dt = expf(log_dt[g]), lr = lam_re[g * GP + p], li = lam_im[g * GP + p], dec = expf(lr * dt);
    const float ar = dec * cosf(li * dt), ai = dec * sinf(li * dt), den = lr * lr + li * li;
    const float cr = ((ar - 1.f) * lr + ai * li) / den, ci = (ai * lr - (ar - 1.f) * li) / den;
    float bbr[GH], bbi[GH];
    for (int hh = 0; hh < GH; ++hh) { const float br = b_re[((size_t)g * GP + p) * GH + hh], bi = b_im[((size_t)g * GP + p) * GH + hh]; bbr[hh] = cr * br - ci * bi; bbi[hh] = cr * bi + ci * br; }
    float xr = 0.f, xi = 0.f;
    for (int t = 0; t < SEQ; ++t) {
        const bf16* ur = QKVU + (size_t)(b * SEQ + t) * INW + 3 * AW + g * GH; float br = 0.f, bi = 0.f;
        for (int hh = 0; hh < GH; ++hh) { const float uv = bf2f(ur[hh]); br += bbr[hh] * uv; bi += bbi[hh] * uv; }
        const float nr = ar * xr - ai * xi + br, ni = ar * xi + ai * xr + bi; xr = nr; xi = ni;
        __syncthreads(); xs[0][p] = xr; xs[1][p] = xi; __syncthreads();
        if (p < GH) { float y = 0.f; for (int q = 0; q < GP; ++q) y += xs[0][q] * c_re[((size_t)g * GH + p) * GP + q] - xs[1][q] * c_im[((size_t)g * GH + p) * GP + q];
            y += dsk[g * GH + p] * bf2f(ur[p]); Yact[(size_t)(b * SEQ + t) * SW + g * GH + p] = (bf16)f2bf(gelu_tanh(y)); }
    }
}
__global__ void __launch_bounds__(256) k_rowss(const bf16* Amix, float* sss) {
    __shared__ float s1[256]; const int row = blockIdx.x; float q = 0;
    for (int c = threadIdx.x; c < SW; c += 256) { const float v = bf2f(Amix[(size_t)row * DM + AW + c]); q += v * v; }
    s1[threadIdx.x] = q; __syncthreads();
    for (int o = 128; o > 0; o >>= 1) { if (threadIdx.x < o) s1[threadIdx.x] += s1[threadIdx.x + o]; __syncthreads(); }
    if (threadIdx.x == 0) sss[row] = s1[0];
}
__global__ void __launch_bounds__(256) k_rs(const float* ssa, const float* sss, float* rsa, float* rss) {
    const int row = blockIdx.x * 256 + threadIdx.x; if (row >= MTOK) return;
    rsa[row] = rsqrtf(ssa[row] * (1.f / AW) + LN_EPS); rss[row] = rsqrtf(sss[row] * (1.f / SW) + LN_EPS);
}

extern "C" void kernel_launch(void* const* d_in, const int* in_sizes, int n_in, void* d_out, int out_size, void* d_ws, size_t ws_size, hipStream_t stream) {
    if (n_in != 30 || out_size != MTOK * DM || ws_size < WS_END) { fprintf(stderr, "kernel_launch: unexpected problem (n_in %d out %d ws %zu)\n", n_in, out_size, ws_size); return; }
    const float* in[30]; for (int i = 0; i < 30; ++i) in[i] = (const float*)d_in[i];
    unsigned char* ws = (unsigned char*)d_ws; float* out = (float*)d_out;
    float* ctl = (float*)(ws + WS_CTL); float* mod = (float*)(ws + WS_MOD); float* kmean = (float*)(ws + WS_KMEAN); unsigned* sel = (unsigned*)(ws + WS_SEL);
    bf16 *Wgu1 = (bf16*)(ws + WS_WGU1), *Wd1 = (bf16*)(ws + WS_WD1), *Win = (bf16*)(ws + WS_WIN), *Wglu = (bf16*)(ws + WS_WGLU), *Wout = (bf16*)(ws + WS_WOUT), *Wgu2 = (bf16*)(ws + WS_WGU2), *Wd2 = (bf16*)(ws + WS_WD2);
    bf16 *A = (bf16*)(ws + WS_A), *H = (bf16*)(ws + WS_H), *QKVU = (bf16*)(ws + WS_QKVU), *Yact = (bf16*)(ws + WS_YACT);
    float* R = (float*)(ws + WS_R);
    float *st1 = ctl + CW_STATS1, *st2 = ctl + CW_STATS2, *st3 = ctl + CW_STATS3, *ssa = ctl + CW_SSA, *sss = ctl + CW_SSS;
    float *rsa = st3, *rss = st3 + MTOK;
    hipMemsetAsync(ws + WS_CTL, 0, CTL_BYTES, stream);
    auto nb = [](size_t n) { return (unsigned)((n + 255) / 256); };
    k_mod<<<nb(NMOD * DM), 256, 0, stream>>>(in[1], in[2], in[3], mod);
    k_wt<<<nb((size_t)2 * FF * DM), 256, 0, stream>>>(in[4], in[5], Wgu1, DM, FF, 1, nullptr, nullptr, 0);
    k_wt<<<nb((size_t)FF * DM), 256, 0, stream>>>(in[6], nullptr, Wd1, FF, DM, 0, nullptr, nullptr, 0);
    k_wt<<<nb((size_t)INW * DM), 256, 0, stream>>>(in[9], nullptr, Win, DM, INW, 0, nullptr, nullptr, 0);
    k_wt<<<nb((size_t)SW * SW), 256, 0, stream>>>(in[19], nullptr, Wglu, SW, SW, 0, nullptr, nullptr, 0);
    k_wt<<<nb((size_t)DM * DM), 256, 0, stream>>>(in[22], nullptr, Wout, DM, DM, 0, in[10], in[21], AW);
    k_wt<<<nb((size_t)2 * FF * DM), 256, 0, stream>>>(in[25], in[26], Wgu2, DM, FF, 1, nullptr, nullptr, 0);
    k_wt<<<nb((size_t)FF * DM), 256, 0, stream>>>(in[27], nullptr, Wd2, FF, DM, 0, nullptr, nullptr, 0);
    k_modulate<<<nb((size_t)MTOK * DM), 256, 0, stream>>>(in[0], mod, 0, A);
    k_gemm<true, EpiSwiglu><<<dim3(FF / 64, MTOK / 64), 256, 0, stream>>>(A, Wgu1, MTOK, FF, DM, nullptr, nullptr, EpiSwiglu{H});
    k_gemm<false, EpiResid><<<dim3(DM / 64, MTOK / 64), 256, 0, stream>>>(H, Wd1, MTOK, DM, FF, nullptr, nullptr, EpiResid{in[0], R, nullptr, nullptr, nullptr, mod, 2, 0.5f, nullptr});
    k_rowstats<<<MTOK, 256, 0, stream>>>(R, st1);
    k_ln_apply<<<nb((size_t)MTOK * DM), 256, 0, stream>>>(R, st1, in[7], in[8], mod, 3, A, nullptr);
    k_gemm<false, EpiStoreBf><<<dim3(INW / 64, MTOK / 64), 256, 0, stream>>>(A, Win, MTOK, INW, DM, nullptr, nullptr, EpiStoreBf{QKVU, INW});
    k_kmean<<<NB * NH * NBLK, 128, 0, stream>>>(QKVU, kmean);
    k_sel<<<nb((size_t)NB * NH * SEQ), 256, 0, stream>>>(QKVU, kmean, sel);
    k_attn<<<NB * NH * SEQ, 64, 0, stream>>>(QKVU, sel, A, ssa);
    k_ssm<<<NB * NG, 64, 0, stream>>>(QKVU, in[11], in[12], in[13], in[14], in[15], in[16], in[17], in[18], Yact);
    k_gemm<false, EpiGlu><<<dim3(SW / 64, MTOK / 64), 256, 0, stream>>>(Yact, Wglu, MTOK, SW, SW, nullptr, nullptr, EpiGlu{Yact, in[20], A});
    k_rowss<<<MTOK, 256, 0, stream>>>(A, sss);
    k_rs<<<nb(MTOK), 256, 0, stream>>>(ssa, sss, rsa, rss);
    k_gemm<false, EpiResid><<<dim3(DM / 64, MTOK / 64), 256, 0, stream>>>(A, Wout, MTOK, DM, DM, rsa, rss, EpiResid{nullptr, R, st1, in[7], in[8], mod, 5, 1.0f, nullptr});
    k_rowstats<<<MTOK, 256, 0, stream>>>(R, st2);
    k_ln_apply<<<nb((size_t)MTOK * DM), 256, 0, stream>>>(R, st2, in[23], in[24], mod, 6, A, nullptr);
    k_gemm<true, EpiSwiglu><<<dim3(FF / 64, MTOK / 64), 256, 0, stream>>>(A, Wgu2, MTOK, FF, DM, nullptr, nullptr, EpiSwiglu{H});
    k_gemm<false, EpiResid><<<dim3(DM / 64, MTOK / 64), 256, 0, stream>>>(H, Wd2, MTOK, DM, FF, nullptr, nullptr, EpiResid{nullptr, R, st2, in[23], in[24], mod, 8, 0.5f, nullptr});
    k_rowstats<<<MTOK, 256, 0, stream>>>(R, st3);
    k_ln_apply<<<nb((size_t)MTOK * DM), 256, 0, stream>>>(R, st3, in[28], in[29], mod, 0, nullptr, out);
}
```

```cpp
#include <hip/hip_runtime.h>
#include <cstdio>
#include <cstdint>

constexpr int NB = 4, SEQ = 4096, DM = 2048, MTOK = NB * SEQ, FF = 5632, NH = 8, HD = 128, AW = 1024, SW = 1024;
constexpr int NG = 64, GP = 64, GH = 16, INW = 4096, NMOD = 9, MB = 256, NBLK = SEQ / MB, TOPK = 3;
constexpr float LN_EPS = 1e-5f, ALPHA = 1.189207115002721f, QSCALE = 0.08838834764831845f, LOG2E = 1.4426950408889634f, QS2 = QSCALE * LOG2E;

constexpr size_t MiB = 1u << 20;
constexpr size_t WS_CTL = 0, CTL_BYTES = 4 * MiB;
constexpr size_t WS_WGU1 = 6 * MiB, WS_WD1 = 50 * MiB, WS_WIN = 72 * MiB, WS_WGLU = 88 * MiB, WS_WOUT = 90 * MiB, WS_WGU2 = 98 * MiB, WS_WD2 = 142 * MiB;
constexpr size_t WS_A = 164 * MiB;
constexpr size_t WS_R = 228 * MiB;
constexpr size_t WS_H = 356 * MiB;
constexpr size_t WS_QKVU = WS_H, WS_YACT = WS_H + 128 * MiB;
constexpr size_t WS_SSMTAB = 4 * MiB;
constexpr size_t SSM_COEF = 0, SSM_BCAT = 65536, SSM_CCAT = 65536 + 262144;
constexpr size_t WS_SSP = 532 * MiB;
constexpr size_t SSP_SSS = 524288;
constexpr size_t WS_RSTAT = 534 * MiB;
constexpr size_t RS_SA = 524288, RS_SW = 786432;
constexpr size_t WS_SLOTS = 536 * MiB;
constexpr size_t WS_A2 = 292 * MiB;
constexpr size_t WS_END = 540 * MiB;
constexpr int CW_TMO = 0, CW_BAR = 4096, CW_LNC = 8192;
constexpr int CW_NMAX = 24576;
constexpr int CW_TICKET = 25600;
constexpr int CW_CMAX = 26624;
constexpr int CW_STATS1 = 65536, CW_STATS2 = CW_STATS1 + 2 * MTOK, CW_STATS3 = CW_STATS2 + 2 * MTOK, CW_SSA = CW_STATS3 + 2 * MTOK, CW_SSS = CW_SSA + MTOK;
constexpr int CW_MOD = CW_SSS + MTOK;
constexpr int CW_KMEAN = CW_MOD + NB * NMOD * DM;
constexpr int CW_SHADOW = 524288;
static_assert(CW_KMEAN + NB * NH * NBLK * HD <= CW_SHADOW && (size_t)(2 * CW_SHADOW) * 4 <= CTL_BYTES, "ctl");

constexpr int WAVETAB_LDS = 139264 + 448;
__device__ __forceinline__ int opaque_tid() {
    const unsigned slot = (unsigned)__builtin_amdgcn_s_getreg(((6 - 1) << 11) | (0 << 6) | 4) & 63u;
    const int wv = __builtin_amdgcn_readfirstlane((int)*(const volatile __attribute__((address_space(3))) unsigned char*)(unsigned)(WAVETAB_LDS + slot));
    int l; asm volatile("v_mbcnt_lo_u32_b32 %0, -1, 0\n\tv_mbcnt_hi_u32_b32 %0, -1, %0" : "=v"(l));
    return (wv << 6) | l;
}

namespace pg8 {
#define PG8_LAS __attribute__((address_space(3)))
typedef unsigned short bf16_t;
typedef short bf16x8 __attribute__((ext_vector_type(8)));
typedef float f32x4 __attribute__((ext_vector_type(4)));
typedef unsigned u32x4 __attribute__((ext_vector_type(4)));
constexpr int BM = 256, BK = 64, HALF = 128, HTB = HALF * BK * 2  , STAGE_BYTES = 8 * HTB, NXCD = 8, WGM = 8;

__host__ __device__ __forceinline__ int lds_byte(int r, int c) { const int st = (r >> 4) * 2 + (c >> 5), rr = r & 15, cc = c & 31, ob = rr * 64 + cc * 2; return st * 1024 + (ob ^ (((ob >> 9) & 1) << 5)); }
__host__ __device__ __forceinline__ void stage_rc(int b, int& R, int& C) { const int st = b / 1024, sb = b % 1024, swz = sb ^ (((sb >> 9) & 1) << 5); R = (st >> 1) * 16 + swz / 64; C = (st & 1) * 32 + (swz % 64) / 2; }
__host__ __device__ __forceinline__ int perm32(int rho) { const int n = rho >> 4, i = rho & 15; return 8 * (i >> 2) + 4 * n + (i & 3); }

struct Unit { int pm, pn; };
struct Gemm { const bf16_t* A; const bf16_t* Bt; int M, N, K; };

struct StaticOrder {
    int nM, nN, nwg, G, c, mul = 1;
    __host__ __device__ __forceinline__ void init(int M, int N, int G_, int c_) { nM = M / BM; nN = N / BM; nwg = nM * nN; G = G_; c = c_; }
    __host__ __device__ __forceinline__ bool next(int i, Unit& u) const {
        const long L = (long)(i / mul) * G + c; if (L >= nwg) return false;
        int wgid = (int)L; { const int q = nwg / NXCD, r = nwg % NXCD, xcd = wgid % NXCD, off = wgid / NXCD; wgid = (xcd < r ? xcd * (q + 1) : r * (q + 1) + (xcd - r) * q) + off; }
        const int nig = WGM * nN, gid = wgid / nig, fm = gid * WGM, gsz = (nM - fm) < WGM ? (nM - fm) : WGM;
        u.pm = fm + ((wgid % nig) % gsz); u.pn = (wgid % nig) / gsz; return true;
    }
    __device__ __forceinline__ void a_ready(const Unit&) const {}
    __device__ __forceinline__ void done(const Unit&) const {}
};

__device__ __forceinline__ unsigned cvt_pk_bf16(float lo, float hi) { unsigned r; asm volatile("v_cvt_pk_bf16_f32 %0, %1, %2" : "=v"(r) : "v"(lo), "v"(hi)); return r; }
typedef float f32x2 __attribute__((ext_vector_type(2)));
typedef int i32x8 __attribute__((ext_vector_type(8))); typedef int i32x4v __attribute__((ext_vector_type(4)));
__device__ __forceinline__ i32x8 pg8_cat8(bf16x8 lo, bf16x8 hi) { return __builtin_shufflevector(__builtin_bit_cast(i32x4v, lo), __builtin_bit_cast(i32x4v, hi), 0, 1, 2, 3, 4, 5, 6, 7); }
__device__ __forceinline__ unsigned cvt4_fp8(float a, float b, float c, float d) { int w = 0; w = __builtin_amdgcn_cvt_pk_fp8_f32(__builtin_amdgcn_fmed3f(a, -448.f, 448.f), __builtin_amdgcn_fmed3f(b, -448.f, 448.f), w, false);
    w = __builtin_amdgcn_cvt_pk_fp8_f32(__builtin_amdgcn_fmed3f(c, -448.f, 448.f), __builtin_amdgcn_fmed3f(d, -448.f, 448.f), w, true); return (unsigned)w; }
__device__ __forceinline__ float fsig(float v) { return __builtin_amdgcn_rcpf(1.f + __builtin_amdgcn_exp2f(-1.4426950408889634f * v)); }
__device__ __forceinline__ float bflo(unsigned w) { return __builtin_bit_cast(float, w << 16); }
__device__ __forceinline__ float bfhi(unsigned w) { return __builtin_bit_cast(float, w & 0xffff0000u); }

template <bool F8OUT> struct EpiSwiglu {
    static constexpr bool PERM = true, AFTER_DRAIN = false, HOOK = false;
    bf16_t* H;
    __device__ __forceinline__ void operator()(const f32x4 (&acc)[2][2][4][2], const Unit& u, int wr, int wc, int fr, int fq, int ui) const {
        const int row0 = u.pm * BM + wr * 64 + fr, col0 = u.pn * HALF + wc * 32 + 8 * fq;
#pragma unroll
        for (int ai = 0; ai < 2; ++ai)
#pragma unroll
            for (int m = 0; m < 4; ++m) { bf16_t* rowp = H + (size_t)(row0 + ai * HALF + m * 16) * FF + col0;
                const f32x4 g0 = acc[ai][0][m][0], g1 = acc[ai][0][m][1], u0 = acc[ai][1][m][0], u1 = acc[ai][1][m][1]; f32x4 v0, v1;
#pragma unroll
                for (int e = 0; e < 4; ++e) { v0[e] = g0[e] * fsig(g0[e]) * u0[e]; v1[e] = g1[e] * fsig(g1[e]) * u1[e]; }
                if constexpr (F8OUT) { typedef unsigned u32x2 __attribute__((ext_vector_type(2))); v0 = v0 * 4.f; v1 = v1 * 4.f;
                    *(u32x2*)((unsigned char*)H + (size_t)(row0 + ai * HALF + m * 16) * FF + col0) = (u32x2){cvt4_fp8(v0[0], v0[1], v0[2], v0[3]), cvt4_fp8(v1[0], v1[1], v1[2], v1[3])}; }
                else { u32x4 w; w.x = cvt_pk_bf16(v0[0], v0[1]); w.y = cvt_pk_bf16(v0[2], v0[3]); w.z = cvt_pk_bf16(v1[0], v1[1]); w.w = cvt_pk_bf16(v1[2], v1[3]);
                *(u32x4*)rowp = w; } }
    }
    __device__ __forceinline__ void hook(f32x4 (&)[2][2][4][2], int, int, int) const {}
};
template <bool F8OUT> struct EpiSwigluI8 {
    static constexpr bool PERM = true, AFTER_DRAIN = false, HOOK = false;
    bf16_t* H; const float* sA; const float* sW;
    __device__ __forceinline__ void operator()(const f32x4 (&acc)[2][2][4][2], const Unit& u, int wr, int wc, int fr, int fq, int ui) const {
        const int row0 = u.pm * BM + wr * 64 + fr, col0 = u.pn * HALF + wc * 32 + 8 * fq, wrow0 = u.pn * BM + wc * 32 + 8 * fq;
        const f32x4 sg0 = *(const f32x4*)(sW + wrow0), sg1 = *(const f32x4*)(sW + wrow0 + 4), su0 = *(const f32x4*)(sW + wrow0 + HALF), su1 = *(const f32x4*)(sW + wrow0 + HALF + 4);
#pragma unroll
        for (int ai = 0; ai < 2; ++ai)
#pragma unroll
            for (int m = 0; m < 4; ++m) { const int row = row0 + ai * HALF + m * 16; const float sa = sA[row]; f32x4 v0, v1;
                const f32x4 a00 = acc[ai][0][m][0], a01 = acc[ai][0][m][1], a10 = acc[ai][1][m][0], a11 = acc[ai][1][m][1];
#pragma unroll
                for (int e = 0; e < 4; ++e) { const float g0 = (float)__float_as_int(a00[e]) * (sa * sg0[e]), g1 = (float)__float_as_int(a01[e]) * (sa * sg1[e]);
                    const float u0 = (float)__float_as_int(a10[e]) * (sa * su0[e]), u1 = (float)__float_as_int(a11[e]) * (sa * su1[e]);
                    v0[e] = g0 * fsig(g0) * u0; v1[e] = g1 * fsig(g1) * u1; }
                if constexpr (F8OUT) { typedef unsigned u32x2 __attribute__((ext_vector_type(2))); v0 = v0 * 4.f; v1 = v1 * 4.f;
                    *(u32x2*)((unsigned char*)H + (size_t)row * FF + col0) = (u32x2){cvt4_fp8(v0[0], v0[1], v0[2], v0[3]), cvt4_fp8(v1[0], v1[1], v1[2], v1[3])}; }
                else { u32x4 w; w.x = cvt_pk_bf16(v0[0], v0[1]); w.y = cvt_pk_bf16(v0[2], v0[3]); w.z = cvt_pk_bf16(v1[0], v1[1]); w.w = cvt_pk_bf16(v1[2], v1[3]);
                    *(u32x4*)(H + (size_t)row * FF + col0) = w; } }
    }
    __device__ __forceinline__ void hook(f32x4 (&)[2][2][4][2], int, int, int) const {}
};
struct EpiQKVU {
    static constexpr bool PERM = true, AFTER_DRAIN = false, HOOK = false;
    bf16_t* O; float* kmean;
    __device__ __forceinline__ void operator()(const f32x4 (&acc)[2][2][4][2], const Unit& u, int wr, int wc, int fr, int fq, int ui) const {
        const int row0 = u.pm * BM + wr * 64 + fr, col0 = u.pn * BM + wc * 32 + 8 * fq;
        const float sc = (u.pn < 4) ? QS2 : 1.f;
#pragma unroll
        for (int ai = 0; ai < 2; ++ai)
#pragma unroll
            for (int m = 0; m < 4; ++m) { bf16_t* rowp = O + (size_t)(row0 + ai * HALF + m * 16) * INW + col0;
#pragma unroll
                for (int bj = 0; bj < 2; ++bj) { const f32x4 v0 = acc[ai][bj][m][0] * sc, v1 = acc[ai][bj][m][1] * sc;
                    u32x4 w; w.x = cvt_pk_bf16(v0[0], v0[1]); w.y = cvt_pk_bf16(v0[2], v0[3]); w.z = cvt_pk_bf16(v1[0], v1[1]); w.w = cvt_pk_bf16(v1[2], v1[3]);
                    *(u32x4*)(rowp + bj * HALF) = w; } }
        if (u.pn >= 4 && u.pn < 8) {
            const int b = u.pm >> 4, j = u.pm & 15;
#pragma unroll
            for (int bj = 0; bj < 2; ++bj)
#pragma unroll
                for (int n = 0; n < 2; ++n) { f32x4 s = (f32x4){0.f, 0.f, 0.f, 0.f};
#pragma unroll
                    for (int ai = 0; ai < 2; ++ai)
#pragma unroll
                        for (int m = 0; m < 4; ++m) s += acc[ai][bj][m][n];
#pragma unroll
                    for (int e = 0; e < 4; ++e) { float v = s[e]; v += __shfl_xor(v, 1); v += __shfl_xor(v, 2); v += __shfl_xor(v, 4); v += __shfl_xor(v, 8); s[e] = v; }
                    if (fr == 0) { const int ck = (u.pn - 4) * BM + bj * HALF + wc * 32 + 8 * fq + 4 * n, h = ck >> 7, d = ck & 127;
                        float* kp = kmean + ((size_t)((b * NH + h) * NBLK + j)) * HD + d;
#pragma unroll
                        for (int e = 0; e < 4; ++e) atomicAdd(kp + e, s[e] * (1.f / MB)); } }
        }
    }
    __device__ __forceinline__ void hook(f32x4 (&)[2][2][4][2], int, int, int) const {}
};
struct EpiGlu {
    static constexpr bool PERM = true, AFTER_DRAIN = false, HOOK = false;
    const bf16_t* Y; const float* bias; bf16_t* Amix; float* sss;
    __device__ __forceinline__ void operator()(const f32x4 (&acc)[2][2][4][2], const Unit& u, int wr, int wc, int fr, int fq, int ui) const {
        const int row0 = u.pm * BM + wr * 64 + fr, col0 = u.pn * BM + wc * 32 + 8 * fq;
        f32x4 bv[2][2];
#pragma unroll
        for (int bj = 0; bj < 2; ++bj)
#pragma unroll
            for (int n = 0; n < 2; ++n) bv[bj][n] = *(const f32x4*)(bias + col0 + bj * HALF + 4 * n);
#pragma unroll
        for (int ai = 0; ai < 2; ++ai)
#pragma unroll
            for (int m = 0; m < 4; ++m) { const int row = row0 + ai * HALF + m * 16; float ssq = 0.f;
#pragma unroll
                for (int bj = 0; bj < 2; ++bj) { const u32x4 yv = *(const u32x4*)(Y + (size_t)row * SW + col0 + bj * HALF);
                    const f32x4 a0 = acc[ai][bj][m][0] + bv[bj][0], a1 = acc[ai][bj][m][1] + bv[bj][1]; f32x4 z0, z1;
                    z0[0] = bflo(yv.x) * fsig(a0[0]); z0[1] = bfhi(yv.x) * fsig(a0[1]); z0[2] = bflo(yv.y) * fsig(a0[2]); z0[3] = bfhi(yv.y) * fsig(a0[3]);
                    z1[0] = bflo(yv.z) * fsig(a1[0]); z1[1] = bfhi(yv.z) * fsig(a1[1]); z1[2] = bflo(yv.w) * fsig(a1[2]); z1[3] = bfhi(yv.w) * fsig(a1[3]);
                    ssq += (z0[0] * z0[0] + z0[1] * z0[1]) + (z0[2] * z0[2] + z0[3] * z0[3]) + (z1[0] * z1[0] + z1[1] * z1[1]) + (z1[2] * z1[2] + z1[3] * z1[3]);
                    u32x4 w; w.x = cvt_pk_bf16(z0[0], z0[1]); w.y = cvt_pk_bf16(z0[2], z0[3]); w.z = cvt_pk_bf16(z1[0], z1[1]); w.w = cvt_pk_bf16(z1[2], z1[3]);
                    *(u32x4*)(Amix + (size_t)row * DM + AW + col0 + bj * HALF) = w; }
                ssq += __shfl_xor(ssq, 16); ssq += __shfl_xor(ssq, 32);
                if (fq == 0) sss[(size_t)row * 16 + u.pn * 4 + wc] = ssq; }
    }
    __device__ __forceinline__ void hook(f32x4 (&)[2][2][4][2], int, int, int) const {}
};
template <bool MIX, bool HALFG> struct EpiResid {
    static constexpr bool PERM = true, AFTER_DRAIN = false, HOOK = MIX;
    const float* xin; const bf16_t* R; bf16_t* Rout; bf16_t* Rdry; int mul; const float* stats_in  ; const float* lng; const float* lnb; const float* modgate  ; const PG8_LAS float* fac  ;
    const float* invmod  ;
    __device__ __forceinline__ void operator()(const f32x4 (&acc)[2][2][4][2], const Unit& u, int wr, int wc, int fr, int fq, int ui) const {
        const int row0 = u.pm * BM + wr * 64 + fr, col0 = u.pn * BM + wc * 32 + 8 * fq, b = u.pm >> 4; constexpr float gm = HALFG ? 0.5f : 1.0f;
        bf16_t* const Ro = (mul > 1 && (ui % mul) != mul - 1) ? Rdry : Rout;
        f32x4 gv[2][2], lg[2][2], lb[2][2];
#pragma unroll
        for (int bj = 0; bj < 2; ++bj)
#pragma unroll
            for (int n = 0; n < 2; ++n) { const int c = col0 + bj * HALF + 4 * n;
                gv[bj][n] = (*(const f32x4*)(modgate + (size_t)b * NMOD * DM + c) + 1.f) * gm;
                if (!xin) { if (invmod) { const f32x4 sh = *(const f32x4*)(invmod + (size_t)b * NMOD * DM + c), sc = *(const f32x4*)(invmod + (size_t)b * NMOD * DM + DM + c);
#pragma unroll
                        for (int e4 = 0; e4 < 4; ++e4) { const float iv = 1.f / (1.f + sc[e4]); lg[bj][n][e4] = iv; lb[bj][n][e4] = -sh[e4] * iv; } }
                    else if (lng) { lg[bj][n] = *(const f32x4*)(lng + c); lb[bj][n] = *(const f32x4*)(lnb + c); }
                    else { lg[bj][n] = (f32x4){1.f, 1.f, 1.f, 1.f}; lb[bj][n] = (f32x4){0.f, 0.f, 0.f, 0.f}; } } }
#pragma unroll
        for (int ai = 0; ai < 2; ++ai)
#pragma unroll
        for (int mp = 0; mp < 4; mp += 2) {
            f32x4 xr[2][2][2]; float mean[2], rstd[2];
#pragma unroll
            for (int mm = 0; mm < 2; ++mm) { const int row = row0 + ai * HALF + (mp + mm) * 16; const size_t off = (size_t)row * DM + col0;
                if (xin) {
#pragma unroll
                    for (int bj = 0; bj < 2; ++bj)
#pragma unroll
                        for (int n = 0; n < 2; ++n) xr[mm][bj][n] = *(const f32x4*)(xin + off + bj * HALF + 4 * n);
                } else { if (invmod || !stats_in) { mean[mm] = 0.f; rstd[mm] = 1.f; } else { mean[mm] = stats_in[2 * row]; rstd[mm] = stats_in[2 * row + 1]; }
#pragma unroll
                    for (int bj = 0; bj < 2; ++bj) { const u32x4 w = *(const u32x4*)(R + off + bj * HALF);
                        xr[mm][bj][0] = (f32x4){bflo(w.x), bfhi(w.x), bflo(w.y), bfhi(w.y)}; xr[mm][bj][1] = (f32x4){bflo(w.z), bfhi(w.z), bflo(w.w), bfhi(w.w)}; } } }
#pragma unroll
            for (int mm = 0; mm < 2; ++mm) { const int m = mp + mm, row = row0 + ai * HALF + m * 16; const size_t off = (size_t)row * DM + col0;
                float rm = 1.f; if (MIX) rm = fac[(2 + ui / mul) * BM + ai * HALF + wr * 64 + m * 16 + fr];
#pragma unroll
                for (int bj = 0; bj < 2; ++bj) { f32x4 o[2];
#pragma unroll
                    for (int n = 0; n < 2; ++n) { f32x4 xv = xr[mm][bj][n]; if (!xin) xv = (xv - mean[mm]) * rstd[mm] * lg[bj][n] + lb[bj][n];
                        o[n] = xv * ALPHA + gv[bj][n] * (acc[ai][bj][m][n] * rm); }
                    u32x4 w; w.x = cvt_pk_bf16(o[0][0], o[0][1]); w.y = cvt_pk_bf16(o[0][2], o[0][3]); w.z = cvt_pk_bf16(o[1][0], o[1][1]); w.w = cvt_pk_bf16(o[1][2], o[1][3]);
                    *(u32x4*)(Ro + off + bj * HALF) = w; } }
        }
    }
    __device__ __forceinline__ void hook(f32x4 (&acc)[2][2][4][2], int ui, int wr, int fr) const {
        if constexpr (MIX) {
#pragma unroll
            for (int ai = 0; ai < 2; ++ai)
#pragma unroll
                for (int m = 0; m < 4; ++m) { const float f = fac[(ui / mul) * BM + ai * HALF + wr * 64 + m * 16 + fr];
#pragma unroll
                    for (int bj = 0; bj < 2; ++bj)
#pragma unroll
                        for (int n = 0; n < 2; ++n) acc[ai][bj][m][n] *= f; }
        }
    }
};


template <class Epi, class Sched, bool ALIGN_EPI = false, bool SP2 = false, int F8SC = 0>
__device__ __forceinline__ void gemm_phase(PG8_LAS unsigned char* lds, const Gemm g, const Sched& S, const Epi& E) {
    const int tid = opaque_tid(), wid = __builtin_amdgcn_readfirstlane(tid >> 6), lane = tid & 63, wr = wid >> 2, wc = wid & 3, fr = lane & 15, fq = lane >> 4;
    const int K = g.K, nt = K / BK;
    unsigned voffA[2], voffB[2];
#pragma unroll
    for (int i = 0; i < 2; ++i) { int R, C; stage_rc(tid * 16 + i * 8192, R, C); const int Rb = Epi::PERM ? ((R & ~31) + perm32(R & 31)) : R;
        voffA[i] = (unsigned)(R * K + C) * 2u; voffB[i] = (unsigned)(Rb * K + C) * 2u; }
    const size_t kstep = (size_t)(BK * 2);
    const size_t hstep = (size_t)HALF * K * 2;
    const size_t tstep = 2 * hstep;
    const unsigned ldsw = (unsigned)wid * 1024u;
    const int aoff = lds_byte(wr * 64 + fr, fq * 8), boff = lds_byte(wc * 32 + fr, fq * 8);
#define PG8_SA(b, h) (((b) * 2 + (h)) * HTB)
#define PG8_SB(b, h) ((4 + (b) * 2 + (h)) * HTB)
#define PG8_STAGE(bufoff, gbase, voff) do { _Pragma("unroll") for (int _i = 0; _i < 2; ++_i) { unsigned _vo = (voff)[_i]; if constexpr (F8SC != 0) asm volatile("" : "+v"(_vo));     \
        __builtin_amdgcn_global_load_lds((const unsigned*)((const char*)(gbase) + _vo), (PG8_LAS unsigned*)(lds + (bufoff) + ldsw + _i * 8192), 16, 0, 0); } } while (0)
#define PG8_LDA(dst, b, h) do { _Pragma("unroll") for (int m = 0; m < 4; ++m) _Pragma("unroll") for (int k = 0; k < 2; ++k) dst[m][k] = *(const PG8_LAS bf16x8*)(lds + PG8_SA(b, h) + aoff + m * 2048 + k * 1024); } while (0)
#define PG8_LDB(dst, b, h) do { _Pragma("unroll") for (int n = 0; n < 2; ++n) _Pragma("unroll") for (int k = 0; k < 2; ++k) dst[n][k] = *(const PG8_LAS bf16x8*)(lds + PG8_SB(b, h) + boff + n * 2048 + k * 1024); } while (0)
#define PG8_MMA(ai, bj, At, Bt) do { __builtin_amdgcn_s_setprio(1); _Pragma("unroll") for (int m = 0; m < 4; ++m) _Pragma("unroll") for (int n = 0; n < 2; ++n) { \
        if constexpr (F8SC > 0) acc[ai][bj][m][n] = __builtin_amdgcn_mfma_scale_f32_16x16x128_f8f6f4(pg8_cat8(Bt[n][0], Bt[n][1]), pg8_cat8(At[m][0], At[m][1]), acc[ai][bj][m][n], 0, 0, 0, 0x7f7f7f7f, 0, F8SC * 0x01010101); \
        else if constexpr (F8SC < 0) { _Pragma("unroll") for (int k = 0; k < 2; ++k) acc[ai][bj][m][n] = __builtin_bit_cast(f32x4, __builtin_amdgcn_mfma_i32_16x16x64_i8(__builtin_bit_cast(i32x4v, Bt[n][k]), __builtin_bit_cast(i32x4v, At[m][k]), __builtin_bit_cast(i32x4v, acc[ai][bj][m][n]), 0, 0, 0)); }         else { _Pragma("unroll") for (int k = 0; k < 2; ++k) acc[ai][bj][m][n] = __builtin_amdgcn_mfma_f32_16x16x32_bf16(Bt[n][k], At[m][k], acc[ai][bj][m][n], 0, 0, 0); } } __builtin_amdgcn_s_setprio(0); } while (0)
#define PG8_WAIT_V(n) asm volatile("s_waitcnt vmcnt(" #n ")" ::: "memory")
#define PG8_WAIT_L(n) asm volatile("s_waitcnt lgkmcnt(" #n ")" ::: "memory")
#define PG8_BAR __builtin_amdgcn_s_barrier()
#define PG8_SCHED __builtin_amdgcn_sched_barrier(0)
    Unit cur, nxt; int ui = 0;
    if (!S.next(0, cur)) return;
    f32x4 acc[2][2][4][2];
#pragma unroll
    for (int a = 0; a < 2; ++a)
#pragma unroll
        for (int b = 0; b < 2; ++b)
#pragma unroll
            for (int m = 0; m < 4; ++m)
#pragma unroll
                for (int n = 0; n < 2; ++n) acc[a][b][m][n] = (f32x4){0.f, 0.f, 0.f, 0.f};
    bf16x8 At[4][2], B0[2][2], B1[2][2];
    const char* cA = (const char*)g.A + (size_t)cur.pm * tstep; const char* cB = (const char*)g.Bt + (size_t)cur.pn * tstep;
    S.a_ready(cur);
    if constexpr (SP2) {
        PG8_STAGE(PG8_SB(0, 0), cB, voffB); PG8_STAGE(PG8_SB(0, 1), cB + hstep, voffB); PG8_STAGE(PG8_SA(0, 0), cA, voffA); PG8_STAGE(PG8_SA(0, 1), cA + hstep, voffA);
        if (wr == 1) PG8_BAR;
        PG8_WAIT_V(2); PG8_BAR;
        PG8_STAGE(PG8_SB(1, 0), cB + kstep, voffB); PG8_STAGE(PG8_SA(1, 0), cA + kstep, voffA); PG8_STAGE(PG8_SB(1, 1), cB + hstep + kstep, voffB);
        PG8_WAIT_V(6); PG8_BAR;
    } else {
        PG8_STAGE(PG8_SB(0, 0), cB, voffB); PG8_STAGE(PG8_SA(0, 0), cA, voffA); PG8_STAGE(PG8_SB(0, 1), cB + hstep, voffB); PG8_STAGE(PG8_SA(0, 1), cA + hstep, voffA);
        if (wr == 1) PG8_BAR;
        PG8_WAIT_V(4); PG8_BAR;
        PG8_STAGE(PG8_SB(1, 0), cB + kstep, voffB); PG8_STAGE(PG8_SA(1, 0), cA + kstep, voffA); PG8_STAGE(PG8_SB(1, 1), cB + hstep + kstep, voffB);
        PG8_WAIT_V(6); PG8_BAR;
    }
    for (;;) {
        { int tq_ = tid; asm volatile("" : "+v"(tq_));
#pragma unroll
          for (int i = 0; i < 2; ++i) { int R, C; stage_rc(tq_ * 16 + i * 8192, R, C); const int Rb = Epi::PERM ? ((R & ~31) + perm32(R & 31)) : R;
              voffA[i] = (unsigned)(R * K + C) * 2u; voffB[i] = (unsigned)(Rb * K + C) * 2u; } }
        const bool has_next = S.next(ui + 1, nxt);
        const char* nA = has_next ? (const char*)g.A + (size_t)nxt.pm * tstep : cA; const char* nB = has_next ? (const char*)g.Bt + (size_t)nxt.pn * tstep : cB;
        for (int t = 0; t < nt; t += 2) {
            const bool last = (t == nt - 2);
            const char* a1 = cA + (size_t)(t + 1) * kstep;
            const char* a2 = last ? nA : cA + (size_t)(t + 2) * kstep; const char* b2 = last ? nB : cB + (size_t)(t + 2) * kstep;
            const char* a3 = a2 + kstep; const char* b3 = b2 + kstep;
            if (last && has_next) S.a_ready(nxt);
            if constexpr (Epi::HOOK) { if (t == (nt >> 1)) E.hook(acc, ui, wr, fr); }
            if constexpr (SP2) {
            PG8_LDB(B0, 0, 0); PG8_LDB(B1, 0, 1); PG8_SCHED; PG8_LDA(At, 0, 0); PG8_STAGE(PG8_SA(1, 1), a1 + hstep, voffA);
            PG8_WAIT_V(8); PG8_WAIT_L(0); PG8_BAR; PG8_MMA(0, 0, At, B0); PG8_MMA(0, 1, At, B1); PG8_BAR; PG8_SCHED;
            PG8_LDA(At, 0, 1); PG8_STAGE(PG8_SB(0, 0), b2, voffB); PG8_STAGE(PG8_SB(0, 1), b2 + hstep, voffB); PG8_STAGE(PG8_SA(0, 0), a2, voffA);
            PG8_WAIT_V(8); PG8_WAIT_L(0); PG8_BAR; PG8_MMA(1, 0, At, B0); PG8_MMA(1, 1, At, B1); PG8_BAR; PG8_SCHED;
            PG8_LDB(B0, 1, 0); PG8_LDB(B1, 1, 1); PG8_SCHED; PG8_LDA(At, 1, 0); PG8_STAGE(PG8_SA(0, 1), a2 + hstep, voffA);
            PG8_WAIT_V(8); PG8_WAIT_L(0); PG8_BAR; PG8_MMA(0, 0, At, B0); PG8_MMA(0, 1, At, B1); PG8_BAR; PG8_SCHED;
            PG8_LDA(At, 1, 1); PG8_STAGE(PG8_SB(1, 0), b3, voffB); PG8_STAGE(PG8_SB(1, 1), b3 + hstep, voffB); PG8_STAGE(PG8_SA(1, 0), a3, voffA);
            PG8_WAIT_V(8); PG8_WAIT_L(0); PG8_BAR; PG8_MMA(1, 0, At, B0); PG8_MMA(1, 1, At, B1); PG8_BAR; PG8_SCHED;
            } else {
            PG8_LDB(B0, 0, 0); PG8_SCHED; PG8_LDA(At, 0, 0); PG8_STAGE(PG8_SA(1, 1), a1 + hstep, voffA);
            PG8_WAIT_L(8); PG8_BAR; PG8_WAIT_L(0); PG8_MMA(0, 0, At, B0); PG8_BAR; PG8_SCHED;
            PG8_LDB(B1, 0, 1); PG8_STAGE(PG8_SB(0, 0), b2, voffB);
            PG8_BAR; PG8_WAIT_L(0); PG8_MMA(0, 1, At, B1); PG8_BAR;
            PG8_LDA(At, 0, 1); PG8_STAGE(PG8_SA(0, 0), a2, voffA);
            PG8_BAR; PG8_WAIT_L(0); PG8_MMA(1, 0, At, B0); PG8_BAR; PG8_SCHED;
            PG8_STAGE(PG8_SB(0, 1), b2 + hstep, voffB);
            PG8_WAIT_V(6); PG8_BAR; PG8_MMA(1, 1, At, B1); PG8_BAR;
            PG8_LDB(B0, 1, 0); PG8_SCHED; PG8_LDA(At, 1, 0); PG8_STAGE(PG8_SA(0, 1), a2 + hstep, voffA);
            PG8_WAIT_L(8); PG8_BAR; PG8_WAIT_L(0); PG8_MMA(0, 0, At, B0); PG8_BAR; PG8_SCHED;
            PG8_LDB(B1, 1, 1); PG8_STAGE(PG8_SB(1, 0), b3, voffB);
            PG8_BAR; PG8_WAIT_L(0); PG8_MMA(0, 1, At, B1); PG8_BAR;
            PG8_LDA(At, 1, 1); PG8_STAGE(PG8_SA(1, 0), a3, voffA);
            PG8_BAR; PG8_WAIT_L(0); PG8_MMA(1, 0, At, B0); PG8_BAR; PG8_SCHED;
            PG8_STAGE(PG8_SB(1, 1), b3 + hstep, voffB);
            PG8_WAIT_V(6); PG8_BAR; PG8_MMA(1, 1, At, B1); PG8_BAR;
            }
        }
        if constexpr (ALIGN_EPI) { if (wr == 0) PG8_BAR; }
        if constexpr (!Epi::AFTER_DRAIN) { { const int l2_ = opaque_tid() & 63; E(acc, cur, wr, wc, l2_ & 15, l2_ >> 4, ui); }     S.done(cur); }
        if (!has_next) break;
#pragma unroll
        for (int a = 0; a < 2; ++a)
#pragma unroll
            for (int b = 0; b < 2; ++b)
#pragma unroll
                for (int m = 0; m < 4; ++m)
#pragma unroll
                    for (int n = 0; n < 2; ++n) acc[a][b][m][n] = (f32x4){0.f, 0.f, 0.f, 0.f};
        cur = nxt; cA = nA; cB = nB; ++ui;
        if constexpr (ALIGN_EPI) { if (wr == 1) PG8_BAR; }
    }
    PG8_WAIT_V(0);
    if constexpr (!ALIGN_EPI) { if (wr == 0) PG8_BAR; }
    PG8_BAR;
    if constexpr (Epi::AFTER_DRAIN) { E.fused(acc, cur, wr, wc, fr, fq, lds, wid, lane); S.done(cur); }
#undef PG8_SA
#undef PG8_SB
#undef PG8_STAGE
#undef PG8_LDA
#undef PG8_LDB
#undef PG8_MMA
#undef PG8_WAIT_V
#undef PG8_WAIT_L
#undef PG8_BAR
#undef PG8_SCHED
}
}

#define GAS __attribute__((address_space(1)))
#define LAS __attribute__((address_space(3)))
typedef unsigned short bf16;
typedef unsigned v4u __attribute__((ext_vector_type(4)));
typedef float f32x4 __attribute__((ext_vector_type(4)));
typedef short bf16x8 __attribute__((ext_vector_type(8)));
typedef GAS unsigned gu32;
typedef GAS unsigned long long gu64;
#define RLX_AGENT __ATOMIC_RELAXED, __HIP_MEMORY_SCOPE_AGENT
#define LDS_WAIT() asm volatile("s_waitcnt lgkmcnt(0)" ::: "memory")
#define VM_WAIT() asm volatile("s_waitcnt vmcnt(0)" ::: "memory")
__device__ __forceinline__ unsigned long long rt() { return __builtin_amdgcn_s_memrealtime(); }
__device__ __forceinline__ unsigned f2bf(float f) { unsigned u = __builtin_bit_cast(unsigned, f); return (u + 0x7fffu + ((u >> 16) & 1u)) >> 16; }
__device__ __forceinline__ unsigned pk2(float lo, float hi) { return f2bf(lo) | (f2bf(hi) << 16); }
#define XB_TMO      128
#define XB_XCNT(j)  (256  + 64 * (j))
#define XB_XSUB(j)  (1280 + 64 * (j))
#define XB_XGEN(j)  (2304 + 64 * (j))
#define XB_TOP      3328
#define XB_TOPGEN   3392
#define XCD_BAR_WORDS 3456
#define XB_SPIN_CAP (1u << 18)

__device__ __forceinline__ unsigned xb_ld(unsigned* p)              { return __hip_atomic_load(p, __ATOMIC_RELAXED, __HIP_MEMORY_SCOPE_AGENT); }
__device__ __forceinline__ unsigned xb_add(unsigned* p, unsigned v) { return __hip_atomic_fetch_add(p, v, __ATOMIC_RELAXED, __HIP_MEMORY_SCOPE_AGENT); }
__device__ __forceinline__ unsigned xb_xcc_id() { return (unsigned)__builtin_amdgcn_s_getreg((3 << 11) | 20) & 0xFu; }
#define XB_SPIN(cond, bar) do { unsigned _sp = 0; while (cond) { __builtin_amdgcn_s_sleep(1); \
    if ((++_sp & 255u) == 0u) { if (xb_ld(&(bar)[XB_TMO])) break; if (_sp > XB_SPIN_CAP) { atomicAdd(&(bar)[XB_TMO], 1u); break; } } } } while (0)

struct XcdBarrier {
    unsigned* bar; unsigned x;
    volatile LAS unsigned* st;
};

__device__ __forceinline__ XcdBarrier xcd_barrier_post(unsigned* bar, volatile LAS unsigned* st) {
    XcdBarrier b; b.bar = bar; b.x = xb_xcc_id(); b.st = st;
    if (threadIdx.x == 0) (void)xb_add(&bar[XB_XCNT(b.x)], 1u);
    return b;
}
__device__ __forceinline__ void xcd_barrier_complete(unsigned* bar, unsigned x, unsigned& nloc, unsigned& nx) {
    const unsigned G = gridDim.x * gridDim.y * gridDim.z;
    unsigned sum, cnt, mine, sp = 0u;
    for (;;) {
        sum = 0u; cnt = 0u; mine = 0u;
#pragma unroll
        for (unsigned j = 0; j < 16; ++j) { const unsigned c = xb_ld(&bar[XB_XCNT(j)]); sum += c; cnt += (c > 0u) ? 1u : 0u; mine = (j == x) ? c : mine; }
        if (sum == G) break;
        __builtin_amdgcn_s_sleep(1);
        if ((++sp & 255u) == 0u) { if (xb_ld(&bar[XB_TMO])) break; if (sp > XB_SPIN_CAP) { atomicAdd(&bar[XB_TMO], 1u); break; } }
    }
    nloc = mine > 0u ? mine : 1u; nx = cnt > 0u ? cnt : 1u;
}

__device__ __forceinline__ void xcd_barrier(const XcdBarrier& b) {
    asm volatile("s_waitcnt vmcnt(0)" ::: "memory");
    __syncthreads();
    if (threadIdx.x == 0) {
        unsigned* bar = b.bar;
        __builtin_amdgcn_s_waitcnt(0);
        unsigned nloc = b.st[0], nx = b.st[1];
        if (nloc == 0u) { xcd_barrier_complete(bar, b.x, nloc, nx); b.st[0] = nloc; b.st[1] = nx; }
        const unsigned old = xb_add(&bar[XB_XSUB(b.x)], 1u);
        const unsigned gen = old / nloc;
        if (old + 1u == (gen + 1u) * nloc) {
            __builtin_amdgcn_fence(__ATOMIC_RELEASE, "agent");
            asm volatile("s_waitcnt vmcnt(0)" ::: "memory");
            const unsigned og = xb_add(&bar[XB_TOP], 1u);
            const unsigned tg = og / nx;
            if (og + 1u == (tg + 1u) * nx) xb_add(&bar[XB_TOPGEN], 1u);
            else XB_SPIN(xb_ld(&bar[XB_TOPGEN]) == tg, bar);
            __builtin_amdgcn_fence(__ATOMIC_ACQUIRE, "agent");
            xb_add(&bar[XB_XGEN(b.x)], 1u);
            asm volatile("s_waitcnt vmcnt(0)" ::: "memory");
        } else {
            XB_SPIN(xb_ld(&bar[XB_XGEN(b.x)]) == gen, bar);
            __builtin_amdgcn_fence(__ATOMIC_ACQUIRE, "agent");
            asm volatile("s_waitcnt vmcnt(0)" ::: "memory");
        }
    }
    __syncthreads();
}

namespace moba {
typedef short bf16x8 __attribute__((ext_vector_type(8)));
typedef short s16x4 __attribute__((ext_vector_type(4)));
typedef float f32x16 __attribute__((ext_vector_type(16)));
typedef float f32x4 __attribute__((ext_vector_type(4)));
typedef unsigned u32x4 __attribute__((ext_vector_type(4)));
typedef unsigned short bf16e;
constexpr int D = 128, NW = 8, QBLK = 32, KVBLK = 64, QB = NW * QBLK, LP = INW  , OP = DM  ;
constexpr int SHM_V = KVBLK * D * 2, SHM_K = KVBLK * D * 2;
constexpr int LDS_BYTES = 2 * SHM_V + 2 * SHM_K + NW * 64 * 4;
constexpr float THR2 = 11.0f;
#define KSWZ(row, colB) ((row) * 256 + ((colB) ^ (((row) & 7) << 4)))
#define SBAR() __builtin_amdgcn_sched_barrier(0)
__device__ __forceinline__ int v_st(int k, int c) { const int kk = (k & ~0xC) | ((k & 4) << 1) | ((k & 8) >> 1); return ((kk >> 3) * 4 + (c >> 5)) * 512 + ((kk & 7) * 32 + (c & 31)) * 2; }
__device__ __forceinline__ int v_rd_base(int lane) { return ((lane & 3) << 3) | (((lane >> 2) & 3) << 6) | (((lane >> 4) & 1) << 5) | (((lane >> 5) & 1) << 8); }
constexpr int v_rd_off(int d0, int ks, int half) { return d0 * 512 + ks * 4096 + half * 2048; }
__device__ __forceinline__ int crow(int r, int hi) { return (r & 3) + 8 * (r >> 2) + 4 * hi; }
__device__ __forceinline__ unsigned cvtpk(float lo, float hi) { unsigned r; asm volatile("v_cvt_pk_bf16_f32 %0, %1, %2" : "=v"(r) : "v"(lo), "v"(hi)); return r; }
__device__ __forceinline__ bf16x8 load8(const bf16e* p) { return *reinterpret_cast<const bf16x8*>(p); }
__device__ __forceinline__ void mask_tile(f32x16& p0, f32x16& p1, int dq) {
    const float NEG = -__builtin_inff();
#pragma unroll
    for (int r = 0; r < 16; ++r) { const int c = (r & 3) + 8 * (r >> 2); if (dq - c < 0) p0[r] = NEG; if (dq - c - 32 < 0) p1[r] = NEG; }
}
__device__ __forceinline__ void partialSM(f32x16& p0, f32x16& p1, float& m_reg, float& mn, float& alpha) {
    float pmax = p0[0];
#pragma unroll
    for (int r = 1; r < 16; ++r) pmax = fmaxf(pmax, p0[r]);
#pragma unroll
    for (int r = 0; r < 16; ++r) pmax = fmaxf(pmax, p1[r]);
    { auto rr = __builtin_amdgcn_permlane32_swap(__float_as_uint(pmax), __float_as_uint(pmax), false, false); pmax = fmaxf(__uint_as_float(rr[0]), __uint_as_float(rr[1])); }
    if (__builtin_expect(__all((pmax - m_reg) <= THR2), 1)) { mn = m_reg; alpha = 1.f; }
    else { mn = fmaxf(m_reg, pmax); alpha = __builtin_amdgcn_exp2f(m_reg - mn); m_reg = mn; }
#pragma unroll
    for (int r = 0; r < 16; ++r) p0[r] = p0[r] - mn;
#pragma unroll
    for (int r = 0; r < 16; ++r) p1[r] = p1[r] - mn;
#pragma unroll
    for (int r = 0; r < 16; ++r) p0[r] = __builtin_amdgcn_exp2f(p0[r]);
}
__device__ __forceinline__ void finishSM(f32x16& p0, f32x16& p1, float alpha, float& l_reg, bf16x8& pa0, bf16x8& pa1, bf16x8& pa2, bf16x8& pa3) {
#pragma unroll
    for (int r = 0; r < 16; ++r) p1[r] = __builtin_amdgcn_exp2f(p1[r]);
    float ps = 0;
#pragma unroll
    for (int r = 0; r < 16; ++r) ps += p0[r];
#pragma unroll
    for (int r = 0; r < 16; ++r) ps += p1[r];
    { auto rr = __builtin_amdgcn_permlane32_swap(__float_as_uint(ps), __float_as_uint(ps), false, false); ps = __uint_as_float(rr[0]) + __uint_as_float(rr[1]); }
    l_reg = l_reg * alpha + ps;
#define PK4(P, B_, OUT) do { unsigned a0 = cvtpk(P[B_+0], P[B_+1]), a1 = cvtpk(P[B_+2], P[B_+3]);                          \
        unsigned b0 = cvtpk(P[B_+4], P[B_+5]), b1 = cvtpk(P[B_+6], P[B_+7]);                                             \
        auto r0 = __builtin_amdgcn_permlane32_swap(a0, b0, false, false); auto r1 = __builtin_amdgcn_permlane32_swap(a1, b1, false, false); \
        u32x4 w = {r0[0], r1[0], r0[1], r1[1]}; OUT = *reinterpret_cast<bf16x8*>(&w); } while (0)
    PK4(p0, 0, pa0); PK4(p0, 8, pa1); PK4(p1, 0, pa2); PK4(p1, 8, pa3);
#undef PK4
}
template <int KB>
__device__ __forceinline__ void qkt(f32x16& p0, f32x16& p1, const char* K_lds, int r32, int hi, const bf16x8* qr, float bt, float sl2) {
#pragma unroll
    for (int r = 0; r < 16; ++r) { const int c = (r & 3) + 8 * (r >> 2); p0[r] = __builtin_fmaf(sl2, (float)c, bt); p1[r] = __builtin_fmaf(sl2, (float)(c + 32), bt); }
    const char* kb[4];
#pragma unroll
    for (int dd = 0; dd < 4; ++dd) kb[dd] = K_lds + KB * SHM_K + KSWZ(r32, (dd * 16 + hi * 8) * 2);
#pragma unroll
    for (int d0 = 0; d0 < 8; ++d0) { const char* a = kb[d0 & 3] + (d0 >> 2) * 128;
        bf16x8 b0 = *reinterpret_cast<const bf16x8*>(a);
        bf16x8 b1 = *reinterpret_cast<const bf16x8*>(a + 32 * 256);
        p0 = __builtin_amdgcn_mfma_f32_32x32x16_bf16(b0, qr[d0], p0, 0, 0, 0);
        p1 = __builtin_amdgcn_mfma_f32_32x32x16_bf16(b1, qr[d0], p1, 0, 0, 0); }
}
template <int VB>
__device__ __forceinline__ void pv_tile(f32x16* o, int vb0, bf16x8 pa0, bf16x8 pa1, bf16x8 pa2, bf16x8 pa3) {
#define TRRD(dst, off) asm volatile("ds_read_b64_tr_b16 %0, %1 offset:%2" : "=&v"(dst) : "v"(vb0), "i"(off) : "memory")
#define PV_D0(d0) do { s16x4 l0, l1, l2, l3, h0, h1, h2, h3; constexpr int b_ = VB * SHM_V + v_rd_off(d0, 0, 0); \
        TRRD(l0, b_); TRRD(h0, b_ + 2048); TRRD(l1, b_ + 4096); TRRD(h1, b_ + 6144); TRRD(l2, b_ + 8192); TRRD(h2, b_ + 10240); TRRD(l3, b_ + 12288); TRRD(h3, b_ + 14336); \
        asm volatile("s_waitcnt lgkmcnt(0)" ::: "memory"); SBAR();   \
        o[d0] = __builtin_amdgcn_mfma_f32_32x32x16_bf16(pa0, (bf16x8){l0[0], l0[1], l0[2], l0[3], h0[0], h0[1], h0[2], h0[3]}, o[d0], 0, 0, 0);   \
        o[d0] = __builtin_amdgcn_mfma_f32_32x32x16_bf16(pa1, (bf16x8){l1[0], l1[1], l1[2], l1[3], h1[0], h1[1], h1[2], h1[3]}, o[d0], 0, 0, 0);   \
        o[d0] = __builtin_amdgcn_mfma_f32_32x32x16_bf16(pa2, (bf16x8){l2[0], l2[1], l2[2], l2[3], h2[0], h2[1], h2[2], h2[3]}, o[d0], 0, 0, 0);   \
        o[d0] = __builtin_amdgcn_mfma_f32_32x32x16_bf16(pa3, (bf16x8){l3[0], l3[1], l3[2], l3[3], h3[0], h3[1], h3[2], h3[3]}, o[d0], 0, 0, 0); } while (0)
    PV_D0(0); PV_D0(1); PV_D0(2); PV_D0(3);
#undef PV_D0
#undef TRRD
}
struct BlockRef { const bf16e* Q; const bf16e* K; const bf16e* V; bf16e* O; const float* km; float* ssa; int ib; float sl2; };
struct Seam { bf16x8 qr[8]; bf16x8 st_v0, st_v1, st_k0, st_k1; };
#define ROW(p, k0, rr) ((p) + (size_t)((k0) + (rr)) * LP + sc)
#define VMW() asm volatile("s_waitcnt vmcnt(0)" ::: "memory")
#define VMWN(n) asm volatile("s_waitcnt vmcnt(%0)" :: "i"(n) : "memory")
#define SLOAD_H(Kp, Vp, k0) do { S.st_v0 = load8(ROW(Vp, k0, sr)); S.st_v1 = load8(ROW(Vp, k0, 32 + sr)); S.st_k0 = load8(ROW(Kp, k0, sr)); S.st_k1 = load8(ROW(Kp, k0, 32 + sr)); } while (0)
#define SWRITE_HK(bf) do { *(bf16x8*)(K_lds + (bf) * SHM_K + kws) = S.st_k0; *(bf16x8*)(K_lds + (bf) * SHM_K + kws + 32 * 256) = S.st_k1; } while (0)
#define SWRITE_HV(bf) do { *(bf16x8*)(V_lds + (bf) * SHM_V + vst0) = S.st_v0; *(bf16x8*)(V_lds + (bf) * SHM_V + vst1) = S.st_v1; } while (0)
#define SWRITE_H(bf) do { SWRITE_HV(bf); SWRITE_HK(bf); } while (0)
__device__ __forceinline__ void prime(const BlockRef& cur, char* lds, Seam& S) {
    const int tid = opaque_tid(), wid = __builtin_amdgcn_readfirstlane(tid >> 6), lane = tid & 63, r32 = lane & 31, hi = lane >> 5;
    const int sr = tid >> 4, sc = (tid & 15) * 8, kws = KSWZ(sr, sc * 2); char* K_lds = lds + 2 * SHM_V;
#pragma unroll
    for (int d0 = 0; d0 < 8; ++d0) S.qr[d0] = load8(cur.Q + (size_t)(wid * QBLK + r32) * LP + d0 * 16 + hi * 8);
    S.st_k0 = load8(ROW(cur.K, 0, sr)); S.st_k1 = load8(ROW(cur.K, 0, 32 + sr)); VMW(); SWRITE_HK(0);
    __syncthreads();
}
__device__ __forceinline__ void block(const BlockRef& cur, const BlockRef& nxt, char* lds, Seam& S) {
    const int tid = opaque_tid(), wid = __builtin_amdgcn_readfirstlane(tid >> 6), lane = tid & 63, r32 = lane & 31, hi = lane >> 5;
    const int P0 = cur.ib * QB, NT = 4 * (cur.ib + 1);
    const int qlo = P0 + wid * QBLK, qm = qlo + r32 - 4 * hi;
    char* V_lds = lds; char* K_lds = lds + 2 * SHM_V;
    float* ws = (float*)(lds + 2 * SHM_V + 2 * SHM_K) + wid * 64; float* li_l = ws, * al_l = ws + 32;
    float m_reg = -1e30f, l_reg = 0; f32x16 o[4] = {};
    const int sr = tid >> 4, sc = (tid & 15) * 8, vst0 = v_st(sr, sc), vst1 = v_st(32 + sr, sc), kws = KSWZ(sr, sc * 2);
    const int vb0 = (int)(uintptr_t)V_lds + v_rd_base(lane);
    const bf16e* Kh = cur.K; const bf16e* Vh = cur.V;
    const float sl2 = cur.sl2;
    S.st_v0 = load8(ROW(Vh, 0, sr)); S.st_v1 = load8(ROW(Vh, 0, 32 + sr));
    unsigned selmask;
    {
        { const int j = sr & 15; const float* kmr = cur.km + j * D + sc; const f32x4 a = *(const f32x4*)kmr, b = *(const f32x4*)(kmr + 4);
          u32x4 hw = {cvtpk(a[0], a[1]), cvtpk(a[2], a[3]), cvtpk(b[0], b[1]), cvtpk(b[2], b[3])};
          if (sr >= 16) { float rsd[8];
#pragma unroll
              for (int e = 0; e < 4; ++e) { const unsigned w = hw[e]; rsd[2 * e] = (e < 2 ? a[2 * e] : b[2 * e - 4]) - __builtin_bit_cast(float, w << 16); rsd[2 * e + 1] = (e < 2 ? a[2 * e + 1] : b[2 * e - 3]) - __builtin_bit_cast(float, w & 0xffff0000u); }
              hw = (u32x4){cvtpk(rsd[0], rsd[1]), cvtpk(rsd[2], rsd[3]), cvtpk(rsd[4], rsd[5]), cvtpk(rsd[6], rsd[7])}; }
          *(u32x4*)(K_lds + SHM_K + kws) = hw; }
        __syncthreads();
        f32x16 g = {};
        const char* kb[4];
#pragma unroll
        for (int dd = 0; dd < 4; ++dd) kb[dd] = K_lds + SHM_K + KSWZ(r32, (dd * 16 + hi * 8) * 2);
#pragma unroll
        for (int d0 = 0; d0 < 8; ++d0) { const bf16x8 b0 = *reinterpret_cast<const bf16x8*>(kb[d0 & 3] + (d0 >> 2) * 128); g = __builtin_amdgcn_mfma_f32_32x32x16_bf16(b0, S.qr[d0], g, 0, 0, 0); }
        float gv[16];
#pragma unroll
        for (int r8 = 0; r8 < 8; ++r8) { const float s = g[r8] + g[r8 + 8];
            auto rr = __builtin_amdgcn_permlane32_swap(__float_as_uint(s), __float_as_uint(s), false, false);
            const int j0 = (r8 & 3) + 8 * (r8 >> 2); gv[j0] = __uint_as_float(rr[0]); gv[j0 + 4] = __uint_as_float(rr[1]); }
        const float NEG = -__builtin_inff();
#pragma unroll
        for (int j = 0; j < 16; ++j) if (j >= cur.ib) gv[j] = NEG;
        selmask = 0u;
#pragma unroll
        for (int rep = 0; rep < 3; ++rep) { float best = NEG; int bi = 0;
#pragma unroll
            for (int j = 0; j < 16; ++j) if (gv[j] > best) { best = gv[j]; bi = j; }
            if (best > NEG) selmask |= 1u << bi;
#pragma unroll
            for (int j = 0; j < 16; ++j) if (j == bi) gv[j] = NEG; }
        selmask |= 1u << cur.ib;
        __syncthreads();
    }
#define RESC(a) do { if (__any((a) < 1.f)) { if (hi == 0) al_l[r32] = (a); asm volatile("s_waitcnt lgkmcnt(0)" ::: "memory");              \
                     for (int d_ = 0; d_ < 4; ++d_) for (int r = 0; r < 16; ++r) o[d_][r] *= al_l[crow(r, hi)]; } } while (0)
#define KBASE(t) ((t) * KVBLK)
#define BT(t) (((selmask >> ((t) >> 2)) & 1u) ? sl2 * (float)(KBASE(t) - P0 + 4 * hi) : -__builtin_inff())
#define MASKT(P0_, P1_, t) do { const int kb_ = KBASE(t); if (kb_ + KVBLK - 1 > qlo) mask_tile(P0_, P1_, qm - kb_); } while (0)
    constexpr int NQL = 8;
#define SEAM_K0() do { VMWN(NQL); SWRITE_HK(0); SBAR(); } while (0)
    f32x16 pA0, pA1, pB0, pB1; float mnA, mnB, alA, alB; bf16x8 pa0, pa1, pa2, pa3;
    VMW(); SWRITE_HV(0); SBAR();
    SLOAD_H(Kh, Vh, KBASE(1));
    SBAR(); qkt<0>(pA0, pA1, K_lds, r32, hi, S.qr, BT(0), sl2);
    MASKT(pA0, pA1, 0); partialSM(pA0, pA1, m_reg, mnA, alA);
    VMW(); SWRITE_H(1);
    __syncthreads();
#define HALF_STEP(PX0, PX1, mnX, alX, PY0, PY1, alY, t, KB, VB, SB) do {                                                      \
        SBAR(); qkt<KB>(PX0, PX1, K_lds, r32, hi, S.qr, BT(t), sl2);                                                          \
        finishSM(PY0, PY1, alY, l_reg, pa0, pa1, pa2, pa3); SBAR();                                                           \
        if ((t) + 1 < NT) { SLOAD_H(Kh, Vh, KBASE((t) + 1)); SBAR(); }                                                        \
        pv_tile<VB>(o, vb0, pa0, pa1, pa2, pa3); MASKT(PX0, PX1, (t)); partialSM(PX0, PX1, m_reg, mnX, alX);                  \
        __syncthreads();                                                                                                      \
        if ((t) + 1 < NT) { VMW(); SWRITE_H(SB); }                                                                            \
        RESC(alX); __syncthreads(); } while (0)
    for (int t = 1; t + 1 < NT; t += 2) {
        HALF_STEP(pB0, pB1, mnB, alB, pA0, pA1, alA, t, 1, 0, 0);
        HALF_STEP(pA0, pA1, mnA, alA, pB0, pB1, alB, t + 1, 0, 1, 1);
    }
    SBAR(); qkt<1>(pB0, pB1, K_lds, r32, hi, S.qr, BT(NT - 1), sl2); SBAR();
    S.st_k0 = load8(ROW(nxt.K, 0, sr)); S.st_k1 = load8(ROW(nxt.K, 0, 32 + sr)); SBAR();
#pragma unroll
    for (int d0 = 0; d0 < 8; ++d0) S.qr[d0] = load8(nxt.Q + (size_t)(wid * QBLK + r32) * LP + d0 * 16 + hi * 8);
    SBAR();
    finishSM(pA0, pA1, alA, l_reg, pa0, pa1, pa2, pa3); SBAR();
    pv_tile<0>(o, vb0, pa0, pa1, pa2, pa3);
    MASKT(pB0, pB1, NT - 1); partialSM(pB0, pB1, m_reg, mnB, alB); __syncthreads(); RESC(alB);
    finishSM(pB0, pB1, alB, l_reg, pa0, pa1, pa2, pa3); SBAR(); pv_tile<1>(o, vb0, pa0, pa1, pa2, pa3);
    SBAR(); SEAM_K0();
    if (hi == 0) li_l[r32] = l_reg; asm volatile("s_waitcnt lgkmcnt(0)" ::: "memory");
    float rli[16];
#pragma unroll
    for (int r = 0; r < 16; ++r) rli[r] = __builtin_amdgcn_rcpf(li_l[crow(r, hi)]);
    bf16e* Ow = cur.O + (size_t)(wid * QBLK) * OP;
#pragma unroll
    for (int r = 0; r < 16; ++r) { const int orow = crow(r, hi); float ssq = 0.f;
#pragma unroll
        for (int d0 = 0; d0 < 4; ++d0) { const float v = o[d0][r] * rli[r]; ssq += v * v;
            const float vn = __shfl_xor(v, 1);
            if ((r32 & 1) == 0) *(unsigned*)(Ow + (size_t)orow * OP + d0 * 32 + r32) = cvtpk(v, vn); }
        ssq += __shfl_xor(ssq, 1); ssq += __shfl_xor(ssq, 2); ssq += __shfl_xor(ssq, 4); ssq += __shfl_xor(ssq, 8); ssq += __shfl_xor(ssq, 16);
        if (r32 == 0) cur.ssa[(size_t)(wid * QBLK + orow) * NH] = ssq; }
    __syncthreads();
#undef RESC
#undef KBASE
#undef BT
#undef MASKT
#undef SEAM_K0
#undef HALF_STEP
}
#undef ROW
#undef VMW
#undef VMWN
#undef SLOAD_H
#undef SWRITE_HK
#undef SWRITE_HV
#undef SWRITE_H
#undef KSWZ
#undef SBAR
}

constexpr int NWAVES = 8;
constexpr int RING_OFF = 0, RING_BYTES = 131072;
constexpr int FAC_OFF = 135168;
constexpr int LDSCTL_OFF = FAC_OFF + 4096, MISC_OFF = LDSCTL_OFF + 320;
constexpr int LDS_BYTES = 147456;
static_assert(MISC_OFF + 128 <= LDSCTL_OFF + 448 && WAVETAB_LDS == LDSCTL_OFF + 448 && WAVETAB_LDS + 64 <= LDS_BYTES, "LDS map");
#ifndef I8_GU1
#define I8_GU1 1
#endif
#ifndef I8_GU2
#define I8_GU2 1
#endif
#ifndef I8_GU
#define I8_GU (I8_GU1 || I8_GU2)
#endif
#ifndef F8_DOWN1
#define F8_DOWN1 1
#endif
#ifndef F8_DOWN2
#define F8_DOWN2 1
#endif
#ifndef MK_PER_PHASE
#define MK_PER_PHASE 0
#endif
constexpr int N_PHASES = 13;

__device__ __forceinline__ float wave_sum(float v) {
#pragma unroll
    for (int o = 1; o < 64; o <<= 1) v += __shfl_xor(v, o);
    return v;
}
__device__ __forceinline__ float fsigm(float v) { return __builtin_amdgcn_rcpf(1.f + __builtin_amdgcn_exp2f(-LOG2E * v)); }
__device__ __forceinline__ float bf2f(unsigned h) { return __builtin_bit_cast(float, h << 16); }
__device__ __forceinline__ float gelu_tanh(float v) { const float u = 0.7978845608028654f * (v + 0.044715f * v * v * v); return v * fsigm(2.f * u); }

__device__ __forceinline__ void p0_transpose_item(const float* W, int K, int N, bf16* WT, int mode, const float* ks, LAS float* scr, int item, int lane) {
    const int nblk = N / 32, kb = item / nblk, nb = item % nblk, k0 = 64 * kb, n0 = 32 * nb;
    const int drow0 = (mode == 0) ? n0 : (256 * (n0 >> 7) + (n0 & 127) + (mode == 2 ? 128 : 0));
    float tv[32];
#pragma unroll
    for (int i = 0; i < 32; ++i) tv[i] = W[(size_t)(k0 + 2 * i + (lane >> 5)) * N + n0 + (lane & 31)];
#pragma unroll
    for (int i = 0; i < 32; ++i) { const int kk = 2 * i + (lane >> 5); float v = tv[i]; if (ks) v *= ks[k0 + kk]; scr[kk * 33 + (lane & 31)] = v; }
    LDS_WAIT(); asm volatile("" ::: "memory");
    const int c = lane & 7;
#pragma unroll
    for (int j = 0; j < 4; ++j) { const int n = (lane >> 3) + 8 * j; const LAS float* s = scr + (8 * c) * 33 + n;
        v4u o; o.x = pk2(s[0 * 33], s[1 * 33]); o.y = pk2(s[2 * 33], s[3 * 33]); o.z = pk2(s[4 * 33], s[5 * 33]); o.w = pk2(s[6 * 33], s[7 * 33]);
        *(GAS v4u*)(WT + (size_t)(drow0 + n) * K + k0 + 8 * c) = o; }
    LDS_WAIT(); asm volatile("" ::: "memory");
}

__device__ __forceinline__ void p0_transpose_item8(const float* W, int K, int N, unsigned char* WT8, float wscale, LAS float* scr, int item, int lane) {
    const int nblk = N / 32, kb = item / nblk, nb = item % nblk, k0 = 64 * kb, n0 = 32 * nb;
    float tv[32];
#pragma unroll
    for (int i = 0; i < 32; ++i) tv[i] = W[(size_t)(k0 + 2 * i + (lane >> 5)) * N + n0 + (lane & 31)];
#pragma unroll
    for (int i = 0; i < 32; ++i) scr[(2 * i + (lane >> 5)) * 33 + (lane & 31)] = tv[i] * wscale;
    LDS_WAIT(); asm volatile("" ::: "memory");
    const int c = lane & 7; typedef unsigned u32x2 __attribute__((ext_vector_type(2)));
#pragma unroll
    for (int j = 0; j < 4; ++j) { const int n = (lane >> 3) + 8 * j; const LAS float* s = scr + (8 * c) * 33 + n;
        *(GAS u32x2*)(WT8 + (size_t)(n0 + n) * K + k0 + 8 * c) = (u32x2){pg8::cvt4_fp8(s[0 * 33], s[1 * 33], s[2 * 33], s[3 * 33]), pg8::cvt4_fp8(s[4 * 33], s[5 * 33], s[6 * 33], s[7 * 33])}; }
    LDS_WAIT(); asm volatile("" ::: "memory");
}

__device__ __forceinline__ void p0_transpose_item_i8(const float* W, int K, int N, signed char* WT8, int mode, const unsigned* cmax, float* sW, LAS float* scr, int item, int lane) {
    const int nblk = N / 32, kb = item / nblk, nb = item % nblk, k0 = 64 * kb, n0 = 32 * nb;
    const int drow0 = 256 * (n0 >> 7) + (n0 & 127) + (mode == 2 ? 128 : 0);
    float tv[32];
#pragma unroll
    for (int i = 0; i < 32; ++i) tv[i] = W[(size_t)(k0 + 2 * i + (lane >> 5)) * N + n0 + (lane & 31)];
#pragma unroll
    for (int i = 0; i < 32; ++i) scr[(2 * i + (lane >> 5)) * 33 + (lane & 31)] = tv[i];
    LDS_WAIT(); asm volatile("" ::: "memory");
    const int c = lane & 7; typedef unsigned u32x2 __attribute__((ext_vector_type(2)));
#pragma unroll
    for (int j = 0; j < 4; ++j) { const int n = (lane >> 3) + 8 * j; const LAS float* s = scr + (8 * c) * 33 + n;
        const float cm = __uint_as_float(__hip_atomic_load(cmax + drow0 + n, __ATOMIC_RELAXED, __HIP_MEMORY_SCOPE_AGENT)), inv = cm > 0.f ? 127.f / cm : 0.f;
        int q[8];
#pragma unroll
        for (int e = 0; e < 8; ++e) q[e] = (int)__builtin_rintf(s[e * 33] * inv) & 0xff;
        *(GAS u32x2*)(WT8 + (size_t)(drow0 + n) * K + k0 + 8 * c) = (u32x2){(unsigned)(q[0] | (q[1] << 8) | (q[2] << 16) | (q[3] << 24)), (unsigned)(q[4] | (q[5] << 8) | (q[6] << 16) | (q[7] << 24))};
        if (kb == 0 && c == 0) sW[drow0 + n] = cm * (1.f / 127.f); }
    LDS_WAIT(); asm volatile("" ::: "memory");
}
__device__ __forceinline__ void p0_colmax_item(const float* W, int N, int mode, unsigned* cmax, int item, int lane) {
    const int ncg = N / 256, cg = item % ncg, kc = item / ncg, n = cg * 256 + 4 * lane;
    f32x4 mx = {0.f, 0.f, 0.f, 0.f};
#pragma unroll 16
    for (int k = 32 * kc; k < 32 * kc + 32; ++k) { const f32x4 w = *(const GAS f32x4*)(W + (size_t)k * N + n); mx[0] = fmaxf(mx[0], fabsf(w[0])); mx[1] = fmaxf(mx[1], fabsf(w[1])); mx[2] = fmaxf(mx[2], fabsf(w[2])); mx[3] = fmaxf(mx[3], fabsf(w[3])); }
    const int drow = 256 * (n >> 7) + (n & 127) + (mode == 2 ? 128 : 0);
#pragma unroll
    for (int e = 0; e < 4; ++e) atomicMax(cmax + drow + e, __float_as_uint(mx[e]));
}

template <bool LN, int OUT, bool SRCBF>
__device__ __forceinline__ void row_phase(const void* src, float* rstat, const float* g, const float* bta, const float* mod, int ishift, bf16* A, float* out, float* sA, bf16* xcopy, int gw, int NGW, int lane) {
    asm volatile("" : "+v"(lane));
    f32x4 v[4][2], nv[4][2];
#define RP_LOAD(dst, m_) do { _Pragma("unroll") for (int j = 0; j < 4; ++j) { \
        if (SRCBF) { const v4u w = *((const GAS v4u*)((const bf16*)src + (size_t)(m_) * DM) + lane + 64 * j); \
            dst[j][0] = (f32x4){bf2f(w.x & 0xffffu), bf2f(w.x >> 16), bf2f(w.y & 0xffffu), bf2f(w.y >> 16)}; dst[j][1] = (f32x4){bf2f(w.z & 0xffffu), bf2f(w.z >> 16), bf2f(w.w & 0xffffu), bf2f(w.w >> 16)}; } \
        else { const GAS f32x4* p = (const GAS f32x4*)((const float*)src + (size_t)(m_) * DM) + 2 * (lane + 64 * j); dst[j][0] = p[0]; dst[j][1] = p[1]; } } } while (0)
    if (gw < MTOK) RP_LOAD(v, gw);
    for (int m = gw; m < MTOK; m += NGW) {
        const int b = m >> 12;
        const f32x4* msh = (const f32x4*)(mod + (size_t)b * NMOD * DM + (size_t)ishift * DM) + 2 * lane; const f32x4* msc = msh + DM / 4;
        const f32x4* gp = (const f32x4*)g + 2 * lane; const f32x4* bp = (const f32x4*)bta + 2 * lane;
        if (m + NGW < MTOK) RP_LOAD(nv, m + NGW);
        float mean = 0.f, rstd = 1.f;
        if (LN) { float s = 0.f;
#pragma unroll
            for (int j = 0; j < 4; ++j)
#pragma unroll
                for (int h = 0; h < 2; ++h) s += (v[j][h][0] + v[j][h][1]) + (v[j][h][2] + v[j][h][3]);
            mean = wave_sum(s) * (1.f / DM); float q = 0.f;
#pragma unroll
            for (int j = 0; j < 4; ++j)
#pragma unroll
                for (int h = 0; h < 2; ++h) { const f32x4 d = v[j][h] - mean; q += (d[0] * d[0] + d[1] * d[1]) + (d[2] * d[2] + d[3] * d[3]); }
            rstd = rsqrtf(wave_sum(q) * (1.f / DM) + LN_EPS);
            if (rstat && lane == 0) { rstat[2 * m] = mean; rstat[2 * m + 1] = rstd; } }
        float amax = 0.f;
#pragma unroll
        for (int j = 0; j < 4; ++j) { f32x4 pre[2];
#pragma unroll
            for (int h = 0; h < 2; ++h) { f32x4 t = v[j][h];
                if (LN) t = (t - mean) * rstd * gp[128 * j + h] + bp[128 * j + h];
                pre[h] = t;
                if (OUT == 0) { ((GAS f32x4*)(out + (size_t)m * DM) + 2 * (lane + 64 * j))[h] = t; }
                else { t = t * (msc[128 * j + h] + 1.f) + msh[128 * j + h];
                    if (OUT == 2) amax = fmaxf(amax, fmaxf(fmaxf(fabsf(t[0]), fabsf(t[1])), fmaxf(fabsf(t[2]), fabsf(t[3])))); }
                v[j][h] = t; }
            if (OUT != 0 && xcopy) { v4u w; w.x = pk2(pre[0][0], pre[0][1]); w.y = pk2(pre[0][2], pre[0][3]); w.z = pk2(pre[1][0], pre[1][1]); w.w = pk2(pre[1][2], pre[1][3]); *((GAS v4u*)(xcopy + (size_t)m * DM) + lane + 64 * j) = w; }
            if (OUT == 1) { const f32x4 t0 = v[j][0], t1 = v[j][1]; v4u w; w.x = pk2(t0[0], t0[1]); w.y = pk2(t0[2], t0[3]); w.z = pk2(t1[0], t1[1]); w.w = pk2(t1[2], t1[3]);
                *((GAS v4u*)(A + (size_t)m * DM) + lane + 64 * j) = w; }
        }
        if (OUT == 2) {
#pragma unroll
            for (int o = 1; o < 64; o <<= 1) amax = fmaxf(amax, __shfl_xor(amax, o));
            const float inv = amax > 0.f ? 127.f / amax : 0.f; if (lane == 0) sA[m] = amax * (1.f / 127.f);
            typedef unsigned u32x2 __attribute__((ext_vector_type(2)));
#pragma unroll
            for (int j = 0; j < 4; ++j) { int q[8];
#pragma unroll
                for (int e = 0; e < 8; ++e) q[e] = (int)__builtin_rintf(v[j][e >> 2][e & 3] * inv) & 0xff;
                *((GAS u32x2*)((unsigned char*)A + (size_t)m * DM) + lane + 64 * j) = (u32x2){(unsigned)(q[0] | (q[1] << 8) | (q[2] << 16) | (q[3] << 24)), (unsigned)(q[4] | (q[5] << 8) | (q[6] << 16) | (q[7] << 24))}; }
        }
#pragma unroll
        for (int j = 0; j < 4; ++j) { v[j][0] = nv[j][0]; v[j][1] = nv[j][1]; }
    }
#undef RP_LOAD
}

__device__ __forceinline__ void attn_query(const bf16* QKVU, const float* kmean, bf16* Amix, float* ssa, int idx, LAS float* scr, int lane) {
    LAS float* sq = scr; LAS float* sp = scr + 256;
    const int t = idx % SEQ, bh = idx / SEQ, b = bh / NH, h = bh % NH, qb = t / MB;
    const float slope2 = __builtin_amdgcn_exp2f(-(float)(h + 1)) * LOG2E;
    const size_t rowq = (size_t)(b * SEQ + t);
    sq[lane] = bf2f(QKVU[rowq * INW + h * HD + lane]); sq[lane + 64] = bf2f(QKVU[rowq * INW + h * HD + lane + 64]);
    LDS_WAIT(); asm volatile("" ::: "memory");
    float gate = 0.f;
    if (lane < NBLK) { const float* km = kmean + ((size_t)bh * NBLK + lane) * HD; for (int d = 0; d < HD; ++d) gate += sq[d] * km[d]; }
    unsigned mask = 0u;
    for (int r = 0; r < TOPK; ++r) {
        const bool cand = (lane < qb) && !((mask >> lane) & 1u);
        const float v = cand ? gate : -INFINITY; float mxv = v;
        mxv = fmaxf(mxv, __shfl_xor(mxv, 8)); mxv = fmaxf(mxv, __shfl_xor(mxv, 4)); mxv = fmaxf(mxv, __shfl_xor(mxv, 2)); mxv = fmaxf(mxv, __shfl_xor(mxv, 1));
        const unsigned long long bal = __ballot(cand && v == mxv) & 0xFFFFull;
        if (bal) mask |= 1u << __builtin_ctzll(bal);
    }
    mask |= 1u << qb;
    float mx = -1e30f; int ns = 0;
    for (int j = 0; j <= qb; ++j) { if (!((mask >> j) & 1u)) continue;
        for (int kk = lane; kk < MB; kk += 64) {
            const int kp = j * MB + kk; float sc = -1e30f;
            if (kp <= t) { const v4u* kr = (const v4u*)(QKVU + (size_t)(b * SEQ + kp) * INW + AW + h * HD); float a = 0.f;
                for (int d8 = 0; d8 < HD / 8; ++d8) { const v4u w = kr[d8]; const LAS float* q8 = sq + 8 * d8;
                    a += q8[0] * bf2f(w.x & 0xffffu) + q8[1] * bf2f(w.x >> 16) + q8[2] * bf2f(w.y & 0xffffu) + q8[3] * bf2f(w.y >> 16)
                       + q8[4] * bf2f(w.z & 0xffffu) + q8[5] * bf2f(w.z >> 16) + q8[6] * bf2f(w.w & 0xffffu) + q8[7] * bf2f(w.w >> 16); }
                sc = a - slope2 * (float)(t - kp); }
            sp[ns * MB + kk] = sc; mx = fmaxf(mx, sc); }
        ++ns; }
    for (int o = 32; o > 0; o >>= 1) mx = fmaxf(mx, __shfl_xor(mx, o));
    float sum = 0.f;
    for (int i = lane; i < ns * MB; i += 64) { const float p = __builtin_amdgcn_exp2f(sp[i] - mx); sp[i] = p; sum += p; }
    sum = wave_sum(sum);
    LDS_WAIT(); asm volatile("" ::: "memory");
    float o0 = 0.f, o1 = 0.f; int s = 0;
    for (int j = 0; j <= qb; ++j) { if (!((mask >> j) & 1u)) continue;
        for (int kk = 0; kk < MB; ++kk) { const int kp = j * MB + kk; if (kp > t) break;
            const float p = sp[s * MB + kk]; const unsigned vv = *(const unsigned*)(QKVU + (size_t)(b * SEQ + kp) * INW + 2 * AW + h * HD + 2 * lane);
            o0 += p * bf2f(vv & 0xffffu); o1 += p * bf2f(vv >> 16); }
        ++s; }
    const float inv = 1.f / sum; o0 *= inv; o1 *= inv;
    *(unsigned*)(Amix + rowq * DM + h * HD + 2 * lane) = pk2(o0, o1);
    const float ss = wave_sum(o0 * o0 + o1 * o1);
    if (lane == 0) atomicAdd(ssa + rowq, ss);
    LDS_WAIT(); asm volatile("" ::: "memory");
}
__device__ __forceinline__ void ssm_unit(const bf16* QKVU, const float* lam_re, const float* lam_im, const float* log_dt, const float* b_re, const float* b_im,
                                         const float* c_re, const float* c_im, const float* dsk, bf16* Yact, int b, int g, LAS float* xs, int p) {
    const float dt = expf(log_dt[g]), lr = lam_re[g * GP + p], li = lam_im[g * GP + p], dec = expf(lr * dt);
    const float ar = dec * cosf(li * dt), ai = dec * sinf(li * dt), den = lr * lr + li * li;
    const float cr = ((ar - 1.f) * lr + ai * li) / den, ci = (ai * lr - (ar - 1.f) * li) / den;
    float bbr[GH], bbi[GH];
#pragma unroll
    for (int hh = 0; hh < GH; ++hh) { const float br = b_re[((size_t)g * GP + p) * GH + hh], bi = b_im[((size_t)g * GP + p) * GH + hh]; bbr[hh] = cr * br - ci * bi; bbi[hh] = cr * bi + ci * br; }
    float xr = 0.f, xi = 0.f;
    for (int t = 0; t < SEQ; ++t) {
        const bf16* ur = QKVU + (size_t)(b * SEQ + t) * INW + 3 * AW + g * GH; float br = 0.f, bi = 0.f;
        const v4u u0 = *(const v4u*)ur, u1 = *(const v4u*)(ur + 8);
        const unsigned uw[8] = {u0.x, u0.y, u0.z, u0.w, u1.x, u1.y, u1.z, u1.w};
#pragma unroll
        for (int hh = 0; hh < 8; ++hh) { const float ua = bf2f(uw[hh] & 0xffffu), ub = bf2f(uw[hh] >> 16); br += bbr[2 * hh] * ua + bbr[2 * hh + 1] * ub; bi += bbi[2 * hh] * ua + bbi[2 * hh + 1] * ub; }
        const float nr = ar * xr - ai * xi + br, ni = ar * xi + ai * xr + bi; xr = nr; xi = ni;
        asm volatile("" ::: "memory"); xs[p] = xr; xs[64 + p] = xi; LDS_WAIT(); asm volatile("" ::: "memory");
        if (p < GH) { float y = 0.f; for (int q = 0; q < GP; ++q) y += xs[q] * c_re[((size_t)g * GH + p) * GP + q] - xs[64 + q] * c_im[((size_t)g * GH + p) * GP + q];
            y += dsk[g * GH + p] * bf2f(ur[p]); Yact[(size_t)(b * SEQ + t) * SW + g * GH + p] = (bf16)f2bf(gelu_tanh(y)); }
        LDS_WAIT(); asm volatile("" ::: "memory");
    }
}


#ifndef PROBE_MASK
#define PROBE_MASK 0
#endif
#define NREP15 (((PROBE_MASK >> 15) & 1) ? 2 : 1)
namespace s5 {
typedef short bf16x8 __attribute__((ext_vector_type(8)));
typedef float f32x16 __attribute__((ext_vector_type(16)));
typedef float f32x2 __attribute__((ext_vector_type(2)));
constexpr int ROWB = 528, WREG = 32 * ROWB, XCH_OFF = 8 * WREG;
static_assert(XCH_OFF == FAC_OFF, "LDS map: S5 wave regions end where the exchange area starts");
__device__ __forceinline__ unsigned cvtpk(float lo, float hi) { unsigned r; asm volatile("v_cvt_pk_bf16_f32 %0, %1, %2" : "=v"(r) : "v"(lo), "v"(hi)); return r; }
__device__ __forceinline__ bf16x8 pack8(const float* v) { v4u w = {cvtpk(v[0], v[1]), cvtpk(v[2], v[3]), cvtpk(v[4], v[5]), cvtpk(v[6], v[7])}; return __builtin_bit_cast(bf16x8, w); }
template <bool FULL>
__device__ __forceinline__ void pass(const bf16* ubase, bf16* ybase, LAS unsigned char* reg, const bf16x8 (&bfr)[4], const bf16x8 (&cfr)[5], float ar, float ai, float& xr, float& xi, int lane) {
    const int j32 = lane & 31, hi = lane >> 5, i16 = lane & 15, q4 = lane >> 4;
    bf16x8 u0 = *(const bf16x8*)(ubase + (size_t)(j32) * INW + 8 * hi), u1 = *(const bf16x8*)(ubase + (size_t)(32 + j32) * INW + 8 * hi);
    bf16x8 u2 = *(const bf16x8*)(ubase + (size_t)(64 + j32) * INW + 8 * hi);
    for (int sc = 0; sc < 16; ++sc) {
        const bf16x8 ua = u0; u0 = u1; u1 = u2;
        if (sc + 3 < 16) u2 = *(const bf16x8*)(ubase + (size_t)(32 * (sc + 3) + j32) * INW + 8 * hi);
        const f32x16 z = {};
#pragma unroll
        for (int nb = 0; nb < 4; ++nb) {
            const f32x16 d = __builtin_amdgcn_mfma_f32_32x32x16_bf16(bfr[nb], ua, z, 0, 0, 0);
#pragma unroll
            for (int q = 0; q < 4; ++q) *(LAS f32x4*)(reg + j32 * ROWB + (32 * nb + 4 * hi + 8 * q) * 4) = (f32x4){d[4 * q], d[4 * q + 1], d[4 * q + 2], d[4 * q + 3]}; }
        asm volatile("s_waitcnt lgkmcnt(0)" ::: "memory");
#pragma unroll
        for (int t8 = 0; t8 < 32; t8 += 8) {
            f32x2 bu[8];
#pragma unroll
            for (int k = 0; k < 8; ++k) bu[k] = *(const LAS f32x2*)(reg + (t8 + k) * ROWB + 8 * lane);
#pragma unroll
            for (int k = 0; k < 8; ++k) { const float nr = __builtin_fmaf(ar, xr, __builtin_fmaf(-ai, xi, bu[k].x)), ni = __builtin_fmaf(ar, xi, __builtin_fmaf(ai, xr, bu[k].y)); xr = nr; xi = ni;
                if (FULL) *(LAS unsigned*)(reg + (t8 + k) * ROWB + 4 * lane) = cvtpk(xr, xi); }
        }
        if (FULL) {
            *(LAS bf16x8*)(reg + j32 * ROWB + 256 + 16 * hi) = ua;
            asm volatile("s_waitcnt lgkmcnt(0)" ::: "memory");
#pragma unroll
            for (int rb = 0; rb < 2; ++rb) { f32x4 y = {0.f, 0.f, 0.f, 0.f};
#pragma unroll
                for (int kc = 0; kc < 4; ++kc) { const bf16x8 a = *(const LAS bf16x8*)(reg + (16 * rb + i16) * ROWB + 64 * kc + 16 * q4); y = __builtin_amdgcn_mfma_f32_16x16x32_bf16(a, cfr[kc], y, 0, 0, 0); }
                { const bf16x8 a = *(const LAS bf16x8*)(reg + (16 * rb + i16) * ROWB + 256 + 16 * (q4 & 1)); y = __builtin_amdgcn_mfma_f32_16x16x32_bf16(a, cfr[4], y, 0, 0, 0); }
#pragma unroll
                for (int e = 0; e < 4; ++e) { const int tok = 32 * sc + 16 * rb + 4 * q4 + e; ybase[(size_t)tok * SW + i16] = (bf16)f2bf(gelu_tanh(y[e])); } }
            asm volatile("s_waitcnt lgkmcnt(0)" ::: "memory");
        }
    }
}
__device__ __forceinline__ void tables(const float* lam_re, const float* lam_im, const float* log_dt, const float* b_re, const float* b_im, const float* c_re, const float* c_im, unsigned char* tab, int g, int p) {
    const float dt = expf(log_dt[g]), lr = lam_re[g * GP + p], li = lam_im[g * GP + p], dec = expf(lr * dt), ar = dec * cosf(li * dt), ai = dec * sinf(li * dt), den = lr * lr + li * li;
    const float d512 = expf(512.f * lr * dt), ang = 512.f * li * dt;
    *(f32x4*)(tab + SSM_COEF + ((size_t)g * GP + p) * 16) = (f32x4){ar, ai, d512 * cosf(ang), d512 * sinf(ang)};
    const float cr = ((ar - 1.f) * lr + ai * li) / den, ci = (ai * lr - (ar - 1.f) * li) / den;
    const float* br = b_re + ((size_t)g * GP + p) * GH; const float* bi = b_im + ((size_t)g * GP + p) * GH;
    float vr[16], vi[16];
#pragma unroll
    for (int e = 0; e < 16; ++e) { vr[e] = cr * br[e] - ci * bi[e]; vi[e] = cr * bi[e] + ci * br[e]; }
    bf16x8* dre = (bf16x8*)(tab + SSM_BCAT + ((size_t)g * 128 + 2 * p) * GH * 2); bf16x8* dim = (bf16x8*)(tab + SSM_BCAT + ((size_t)g * 128 + 2 * p + 1) * GH * 2);
    dre[0] = pack8(vr); dre[1] = pack8(vr + 8); dim[0] = pack8(vi); dim[1] = pack8(vi + 8);
#pragma unroll
    for (int o = 0; o < GH; ++o) *(unsigned*)(tab + SSM_CCAT + (((size_t)g * GH + o) * 128 + 2 * p) * 2) = cvtpk(c_re[((size_t)g * GH + o) * GP + p], -c_im[((size_t)g * GH + o) * GP + p]);
}
__device__ __forceinline__ void unit(const bf16* QKVU, const unsigned char* tab, const float* dsk, bf16* Yact, int b, int g, LAS unsigned char* lds) {
    const int tid = opaque_tid(), lane = tid & 63, w = __builtin_amdgcn_readfirstlane(tid >> 6);
    const int j32 = lane & 31, hi = lane >> 5, i16 = lane & 15, q4 = lane >> 4;
    const f32x4 cf = *(const f32x4*)(tab + SSM_COEF + ((size_t)g * GP + lane) * 16);
    const float ar = cf[0], ai = cf[1], Ar = cf[2], Ai = cf[3];
    bf16x8 bfr[4], cfr[5];
#pragma unroll
    for (int nb = 0; nb < 4; ++nb) bfr[nb] = *(const bf16x8*)(tab + SSM_BCAT + (((size_t)g * 128 + 32 * nb + j32) * GH + 8 * hi) * 2);
#pragma unroll
    for (int kc = 0; kc < 4; ++kc) cfr[kc] = *(const bf16x8*)(tab + SSM_CCAT + (((size_t)g * GH + i16) * 128 + 32 * kc + 8 * q4) * 2);
    { float v[8];
#pragma unroll
      for (int e = 0; e < 8; ++e) v[e] = (q4 < 2 && 8 * q4 + e == i16) ? dsk[g * GH + i16] : 0.f;
      cfr[4] = pack8(v); }
    const bf16* ubase = QKVU + (size_t)(b * SEQ + 512 * w) * INW + 3 * AW + GH * g;
    bf16* ybase = Yact + (size_t)(b * SEQ + 512 * w) * SW + GH * g;
    LAS unsigned char* reg = lds + w * WREG;
    LAS f32x2* xch = (LAS f32x2*)(lds + XCH_OFF);
    float xr = 0.f, xi = 0.f;
    for (int r15 = 0; r15 < NREP15; ++r15) { xr = 0.f; xi = 0.f; pass<false>(ubase, ybase, reg, bfr, cfr, ar, ai, xr, xi, lane); }
    xch[w * 64 + lane] = (f32x2){xr, xi};
    __syncthreads();
    xr = 0.f; xi = 0.f;
    for (int v = 0; v < w; ++v) { const f32x2 e = xch[v * 64 + lane]; const float nr = Ar * xr - Ai * xi + e.x, ni = Ar * xi + Ai * xr + e.y; xr = nr; xi = ni; }
    pass<true>(ubase, ybase, reg, bfr, cfr, ar, ai, xr, xi, lane);
    __syncthreads();
}
}
__device__ __forceinline__ moba::BlockRef attn_ref(const bf16* QKVU, bf16* Amix, const float* kmean, float* ssa, int pi, int which) {
    const int bh = pi >> 3, s = pi & 7, b = bh / NH, h = bh % NH, ib = which ? s : 15 - s;
    moba::BlockRef r;
    r.Q = QKVU + (size_t)(b * SEQ + ib * MB) * INW + h * HD; r.K = QKVU + (size_t)(b * SEQ) * INW + AW + h * HD; r.V = QKVU + (size_t)(b * SEQ) * INW + 2 * AW + h * HD;
    r.O = Amix + (size_t)(b * SEQ + ib * MB) * DM + h * HD; r.km = kmean + (size_t)bh * NBLK * HD; r.ssa = ssa + (size_t)(b * SEQ + ib * MB) * NH + h; r.ib = ib;
    r.sl2 = __builtin_amdgcn_exp2f(-(float)(h + 1)) * LOG2E; return r;
}
struct Args { const float* in[30]; float* out; unsigned char* ws; int ph_lo, ph_hi; };
__global__ void __launch_bounds__(NWAVES * 64, 2) mk_fwd(Args args) {
    extern __shared__ __attribute__((aligned(16))) unsigned char lds_raw[];
    LAS unsigned char* lds = (LAS unsigned char*)lds_raw;
    volatile LAS unsigned* MISC = (volatile LAS unsigned*)(lds + MISC_OFF);
    const int wave = __builtin_amdgcn_readfirstlane((int)threadIdx.x >> 6);
#define PH_TID const int tid = opaque_tid(), lane = tid & 63; (void)lane; (void)tid
    const int G = gridDim.x, bx = blockIdx.x, vcu = (G % 8 == 0) ? (bx % 8) * (G / 8) + bx / 8 : bx;
    const int gw = vcu * NWAVES + wave, NGW = G * NWAVES;
    unsigned char* ws = args.ws;
    float* ctlf = (float*)(ws + WS_CTL); gu32* ctl = (gu32*)(ws + WS_CTL);
    float* mod = ctlf + CW_MOD; float* kmean = ctlf + CW_KMEAN;
    float *st1 = (float*)(ws + WS_RSTAT), *st2 = st1 + 2 * MTOK, *ssa8 = (float*)(ws + WS_SSP), *sss16 = (float*)(ws + WS_SSP + SSP_SSS);
    bf16 *Wgu1 = (bf16*)(ws + WS_WGU1), *Wd1 = (bf16*)(ws + WS_WD1), *Win = (bf16*)(ws + WS_WIN), *Wglu = (bf16*)(ws + WS_WGLU), *Wout = (bf16*)(ws + WS_WOUT), *Wgu2 = (bf16*)(ws + WS_WGU2), *Wd2 = (bf16*)(ws + WS_WD2);
    bf16 *A = (bf16*)(ws + WS_A), *H = (bf16*)(ws + WS_H), *QKVU = (bf16*)(ws + WS_QKVU), *Yact = (bf16*)(ws + WS_YACT);
    float *sA1 = (float*)(ws + WS_RSTAT + RS_SA), *sA2 = sA1 + MTOK, *sW1 = (float*)(ws + WS_RSTAT + RS_SW), *sW2 = sW1 + 2 * FF;
    bf16* R = (bf16*)(ws + WS_R);
    const float* x = args.in[0];
    for (int u = threadIdx.x; u < (LDS_BYTES - LDSCTL_OFF) / 4; u += NWAVES * 64) ((LAS unsigned*)(lds + LDSCTL_OFF))[u] = 0u;
    __syncthreads();
    if ((threadIdx.x & 63) == 0) lds[WAVETAB_LDS + ((unsigned)__builtin_amdgcn_s_getreg(((6 - 1) << 11) | (0 << 6) | 4) & 63u)] = (unsigned char)(threadIdx.x >> 6);
    __syncthreads();
    XcdBarrier bar; bar.bar = (unsigned*)(ctl + CW_BAR); bar.x = 0; bar.st = nullptr;
    if (!MK_PER_PHASE) bar = xcd_barrier_post((unsigned*)(ctl + CW_BAR), MISC + 8);
    const int lo = args.ph_lo, hi = args.ph_hi;
#define IN(k) (lo <= (k) && (k) < hi)
#ifndef PROBE_MASK
#define PROBE_MASK 0
#endif
#define NREP(k) (((PROBE_MASK >> (k)) & 1) ? 2 : 1)
#define PHASE(k) for (int rep = 0; rep < NREP(k); ++rep) if (IN(k))
#define UMUL(bit) (((PROBE_MASK >> (bit)) & 1) ? 2 : 1)
#define SHD(p, k) ((NREP(k) == 2 && rep == 0) ? (p) + CW_SHADOW : (p))
#define SEAM(k) do { if (IN(k) && IN((k) + 1)) { xcd_barrier(bar); if ((PROBE_MASK >> 16) & 1) xcd_barrier(bar); } } while (0)

    PHASE(0) {
        PH_TID;
        LAS float* scr = (LAS float*)(lds + wave * 8704);
        LAS float* sc = (LAS float*)(lds + 73728);
        for (int i = tid; i < NB * DM; i += NWAVES * 64) { const float cv = args.in[1][i]; sc[i] = cv * fsigm(cv); }
        __syncthreads();
        {
            const float* wada = args.in[2]; LAS float* part = (LAS float*)(lds + 106496);
            typedef float f32x2 __attribute__((ext_vector_type(2)));
            for (int cg = vcu; cg < NMOD * DM / 128; cg += G) {
                const int col = cg * 128 + 2 * lane, k0 = wave * (DM / NWAVES);
                f32x2 a0 = {0.f, 0.f}, a1 = a0, a2 = a0, a3 = a0;
#pragma unroll 16
                for (int k = k0; k < k0 + DM / NWAVES; ++k) { const f32x2 w = *(const GAS f32x2*)(wada + (size_t)k * (NMOD * DM) + col);
                    a0 += w * sc[k]; a1 += w * sc[DM + k]; a2 += w * sc[2 * DM + k]; a3 += w * sc[3 * DM + k]; }
                __syncthreads();
                *(LAS f32x2*)(part + (wave * 4 + 0) * 128 + 2 * lane) = a0; *(LAS f32x2*)(part + (wave * 4 + 1) * 128 + 2 * lane) = a1;
                *(LAS f32x2*)(part + (wave * 4 + 2) * 128 + 2 * lane) = a2; *(LAS f32x2*)(part + (wave * 4 + 3) * 128 + 2 * lane) = a3;
                __syncthreads();
                { const int bb = tid >> 7, c = tid & 127; float s = args.in[3][cg * 128 + c];
#pragma unroll
                  for (int w8 = 0; w8 < NWAVES; ++w8) s += part[(w8 * 4 + bb) * 128 + c];
                  mod[(size_t)bb * NMOD * DM + cg * 128 + c] = s; }
            }
        }
        if (I8_GU) {
            unsigned* cm = (unsigned*)(ctl + CW_CMAX); constexpr int IC = (FF / 256) * (DM / 32);
            for (int it = gw; it < 4 * IC; it += NGW) { const int mt = it / IC, r = it % IC;
                p0_colmax_item(args.in[mt == 0 ? 4 : mt == 1 ? 5 : mt == 2 ? 25 : 26], FF, 1 + (mt & 1), cm + (mt >> 1) * 2 * FF, r, lane); }
            if (IN(0) && IN(1)) xcd_barrier(bar);
        }
        if (gw >= NGW - NG) s5::tables(args.in[11], args.in[12], args.in[13], args.in[14], args.in[15], args.in[16], args.in[17], ws + WS_SSMTAB, gw - (NGW - NG), lane);
        {
            constexpr int I_GU = (DM / 64) * (FF / 32), I_D = (FF / 64) * (DM / 32), I_IN = (DM / 64) * (INW / 32), I_GLU = (SW / 64) * (SW / 32), I_OUT = (DM / 64) * (DM / 32);
            constexpr int NITEMS = 4 * I_GU + 2 * I_D + I_IN + I_GLU + I_OUT;
            for (int it = gw; it < NITEMS; it += NGW) {
                int r = it;
                if (r < I_GU) { if (I8_GU1) p0_transpose_item_i8(args.in[4], DM, FF, (signed char*)Wgu1, 1, (const unsigned*)(ctl + CW_CMAX), sW1, scr, r, lane); else p0_transpose_item(args.in[4], DM, FF, Wgu1, 1, nullptr, scr, r, lane); continue; } r -= I_GU;
                if (r < I_GU) { if (I8_GU1) p0_transpose_item_i8(args.in[5], DM, FF, (signed char*)Wgu1, 2, (const unsigned*)(ctl + CW_CMAX), sW1, scr, r, lane); else p0_transpose_item(args.in[5], DM, FF, Wgu1, 2, nullptr, scr, r, lane); continue; } r -= I_GU;
                if (r < I_GU) { if (I8_GU2) p0_transpose_item_i8(args.in[25], DM, FF, (signed char*)Wgu2, 1, (const unsigned*)(ctl + CW_CMAX) + 2 * FF, sW2, scr, r, lane); else p0_transpose_item(args.in[25], DM, FF, Wgu2, 1, nullptr, scr, r, lane); continue; } r -= I_GU;
                if (r < I_GU) { if (I8_GU2) p0_transpose_item_i8(args.in[26], DM, FF, (signed char*)Wgu2, 2, (const unsigned*)(ctl + CW_CMAX) + 2 * FF, sW2, scr, r, lane); else p0_transpose_item(args.in[26], DM, FF, Wgu2, 2, nullptr, scr, r, lane); continue; } r -= I_GU;
                if (r < I_D) { if (F8_DOWN1) p0_transpose_item8(args.in[6], FF, DM, (unsigned char*)Wd1, 128.f, scr, r, lane); else p0_transpose_item(args.in[6], FF, DM, Wd1, 0, nullptr, scr, r, lane); continue; } r -= I_D;
                if (r < I_D) { if (F8_DOWN2) p0_transpose_item8(args.in[27], FF, DM, (unsigned char*)Wd2, 128.f, scr, r, lane); else p0_transpose_item(args.in[27], FF, DM, Wd2, 0, nullptr, scr, r, lane); continue; } r -= I_D;
                if (r < I_GLU) { p0_transpose_item(args.in[19], SW, SW, Wglu, 0, nullptr, scr, r, lane); continue; } r -= I_GLU;
                if (r < I_OUT) { const int kb = r / (DM / 32); const float* ks = (kb < AW / 64) ? args.in[10] : (args.in[21] - AW);
                    p0_transpose_item(args.in[22], DM, DM, Wout, 0, ks, scr, r, lane); continue; } r -= I_OUT;
                p0_transpose_item(args.in[9], DM, INW, Win, 0, nullptr, scr, r, lane);
            }
        }
    }
    SEAM(0);
    PHASE(1) { PH_TID; if (I8_GU1) row_phase<false, 2, false>(x, nullptr, nullptr, nullptr, mod, 0, A, nullptr, sA1, R, gw, NGW, lane);
        else row_phase<false, 1, false>(x, nullptr, nullptr, nullptr, mod, 0, A, nullptr, nullptr, nullptr, gw, NGW, lane); }
    SEAM(1);
    PHASE(2) { pg8::Gemm g{A, Wgu1, MTOK, 2 * FF, I8_GU1 ? DM / 2 : DM}; pg8::StaticOrder S; S.init(MTOK, 2 * FF, G, bx); S.mul = UMUL(17);
        if constexpr (I8_GU1 != 0) { pg8::EpiSwigluI8<F8_DOWN1 != 0> E{H, sA1, sW1}; pg8::gemm_phase<pg8::EpiSwigluI8<F8_DOWN1 != 0>, pg8::StaticOrder, true, true, -1>(lds + RING_OFF, g, S, E); }
        else { pg8::EpiSwiglu<F8_DOWN1 != 0> E{H}; pg8::gemm_phase<pg8::EpiSwiglu<F8_DOWN1 != 0>, pg8::StaticOrder, true, true>(lds + RING_OFF, g, S, E); } }
    SEAM(2);
    PHASE(3) { pg8::Gemm g{H, Wd1, MTOK, DM, F8_DOWN1 ? FF / 2 : FF}; pg8::StaticOrder S; S.init(MTOK, DM, G, bx);
        S.mul = UMUL(18); pg8::EpiResid<false, true> E{nullptr, I8_GU1 ? R : A, R, R, UMUL(18), nullptr, nullptr, nullptr, mod + 2 * DM, nullptr, I8_GU1 ? nullptr : mod};
        pg8::gemm_phase<pg8::EpiResid<false, true>, pg8::StaticOrder, true, true, F8_DOWN1 ? 118 : 0>(lds + RING_OFF, g, S, E); }
    SEAM(3);
    PHASE(4) { PH_TID; row_phase<true, 1, true>(R, st1, args.in[7], args.in[8], mod, 3, A, nullptr, nullptr, nullptr, gw, NGW, lane); }
    SEAM(4);
    PHASE(5) { pg8::Gemm g{A, Win, MTOK, INW, DM}; pg8::StaticOrder S; S.init(MTOK, INW, G, bx); S.mul = UMUL(19); pg8::EpiQKVU E{QKVU, SHD(kmean, 5)};
        pg8::gemm_phase<pg8::EpiQKVU, pg8::StaticOrder, true, true>(lds + RING_OFF, g, S, E); }
    SEAM(5);
    PHASE(6) {
        for (int r13 = 0; r13 < NREP(13); ++r13)
        for (int un = vcu; un < NB * NG; un += G) s5::unit(QKVU, ws + WS_SSMTAB, args.in[18], Yact, un / NG, un % NG, lds);
        for (int r14 = 0; r14 < NREP(14); ++r14) {
        char* alds = (char*)lds_raw; moba::Seam S; bool first = true;
        for (int pi = vcu; pi < NB * NH * 8; pi += G) {
            const moba::BlockRef u0 = attn_ref(QKVU, A, kmean, ssa8, pi, 0), u1 = attn_ref(QKVU, A, kmean, ssa8, pi, 1);
            const moba::BlockRef nx = (pi + G < NB * NH * 8) ? attn_ref(QKVU, A, kmean, ssa8, pi + G, 0) : u1;
            if (first) { moba::prime(u0, alds, S); first = false; }
            moba::block(u0, u1, alds, S); moba::block(u1, nx, alds, S);
        }
        __syncthreads();
        }
    }
    SEAM(6);
    PHASE(7) { pg8::Gemm g{Yact, Wglu, MTOK, SW, SW}; pg8::StaticOrder S; S.init(MTOK, SW, G, bx); S.mul = UMUL(20); pg8::EpiGlu E{Yact, args.in[20], A, sss16};
        pg8::gemm_phase<pg8::EpiGlu, pg8::StaticOrder, true, true>(lds + RING_OFF, g, S, E); }
    SEAM(7);
    PHASE(8) { PH_TID; pg8::Gemm g{A, Wout, MTOK, DM, DM}; pg8::StaticOrder S; S.init(MTOK, DM, G, bx);
        LAS float* fac = (LAS float*)(lds + FAC_OFF);
        for (int i = 0; i < 2; ++i) { pg8::Unit u; if (S.next(i, u) && tid < 256) { const int row = u.pm * 256 + tid;
            const f32x4 a0 = *(const f32x4*)(ssa8 + (size_t)row * 8), a1 = *(const f32x4*)(ssa8 + (size_t)row * 8 + 4);
            const float sa = ((a0[0] + a0[1]) + (a0[2] + a0[3])) + ((a1[0] + a1[1]) + (a1[2] + a1[3])); float sz = 0.f;
#pragma unroll
            for (int k = 0; k < 4; ++k) { const f32x4 z4 = *(const f32x4*)(sss16 + (size_t)row * 16 + 4 * k); sz += (z4[0] + z4[1]) + (z4[2] + z4[3]); }
            const float rsa = rsqrtf(sa * (1.f / AW) + LN_EPS), rss = rsqrtf(sz * (1.f / SW) + LN_EPS);
            fac[i * 256 + tid] = rsa / rss; fac[(2 + i) * 256 + tid] = rss; } }
        __syncthreads();
        S.mul = UMUL(21); pg8::EpiResid<true, false> E{nullptr, R, (NREP(8) == 2 && rep == 0) ? (bf16*)args.out : R, (bf16*)args.out, UMUL(21), st1, args.in[7], args.in[8], mod + 5 * DM, fac, nullptr};
        pg8::gemm_phase<pg8::EpiResid<true, false>, pg8::StaticOrder, true, true>(lds + RING_OFF, g, S, E); }
    SEAM(8);
    PHASE(9) { PH_TID; if (I8_GU2) row_phase<true, 2, true>(R, st2, args.in[23], args.in[24], mod, 6, A, nullptr, sA2, nullptr, gw, NGW, lane);
        else row_phase<true, 1, true>(R, st2, args.in[23], args.in[24], mod, 6, A, nullptr, nullptr, nullptr, gw, NGW, lane); }
    SEAM(9);
    PHASE(10) { pg8::Gemm g{A, Wgu2, MTOK, 2 * FF, I8_GU2 ? DM / 2 : DM}; pg8::StaticOrder S; S.init(MTOK, 2 * FF, G, bx); S.mul = UMUL(22);
        if constexpr (I8_GU2 != 0) { pg8::EpiSwigluI8<F8_DOWN2 != 0> E{H, sA2, sW2}; pg8::gemm_phase<pg8::EpiSwigluI8<F8_DOWN2 != 0>, pg8::StaticOrder, true, true, -1>(lds + RING_OFF, g, S, E); }
        else { pg8::EpiSwiglu<F8_DOWN2 != 0> E{H}; pg8::gemm_phase<pg8::EpiSwiglu<F8_DOWN2 != 0>, pg8::StaticOrder, true, true>(lds + RING_OFF, g, S, E); } }
    SEAM(10);
    PHASE(11) { pg8::Gemm g{H, Wd2, MTOK, DM, F8_DOWN2 ? FF / 2 : FF}; pg8::StaticOrder S; S.init(MTOK, DM, G, bx);
        S.mul = UMUL(23); pg8::EpiResid<false, true> E{nullptr, R, (NREP(11) == 2 && rep == 0) ? (bf16*)args.out : R, (bf16*)args.out, UMUL(23), st2, args.in[23], args.in[24], mod + 8 * DM, nullptr, nullptr};
        pg8::gemm_phase<pg8::EpiResid<false, true>, pg8::StaticOrder, true, true, F8_DOWN2 ? 118 : 0>(lds + RING_OFF, g, S, E); }
    SEAM(11);
    PHASE(12) { PH_TID; row_phase<true, 0, true>(R, nullptr, args.in[28], args.in[29], mod, 0, nullptr, args.out, nullptr, nullptr, gw, NGW, lane); }
#undef IN
#undef SEAM
}

extern "C" void kernel_launch(void* const* d_in, const int* in_sizes, int n_in, void* d_out, int out_size, void* d_ws, size_t ws_size, hipStream_t stream) {
    static int grid = 0;
    if (grid == 0) {
        if (n_in != 30 || out_size != MTOK * DM || ws_size < WS_END) { fprintf(stderr, "kernel_launch: unexpected problem (n_in %d out %d ws %zu)\n", n_in, out_size, ws_size); grid = -1; return; }
        int dev = 0, cus = 0, per_cu = 0;
        if (hipGetDevice(&dev) != hipSuccess || hipDeviceGetAttribute(&cus, hipDeviceAttributeMultiprocessorCount, dev) != hipSuccess) { grid = -1; return; }
        if (hipFuncSetAttribute((const void*)mk_fwd, hipFuncAttributeMaxDynamicSharedMemorySize, LDS_BYTES) != hipSuccess) { fprintf(stderr, "kernel_launch: hipFuncSetAttribute failed\n"); grid = -1; return; }
        if (hipOccupancyMaxActiveBlocksPerMultiprocessor(&per_cu, (const void*)mk_fwd, NWAVES * 64, LDS_BYTES) != hipSuccess || per_cu < 1) { fprintf(stderr, "kernel_launch: occupancy query reports %d\n", per_cu); }
        (void)hipGetLastError();
        grid = cus;
    }
    if (grid < 0) return;
    if (hipMemsetAsync((char*)d_ws + WS_CTL, 0, CTL_BYTES, stream) != hipSuccess) return;
    Args a{};
    for (int i = 0; i < 30; ++i) a.in[i] = (const float*)d_in[i];
    a.out = (float*)d_out; a.ws = (unsigned char*)d_ws;
#if MK_PER_PHASE
    for (int p = 0; p < N_PHASES; ++p) { a.ph_lo = p; a.ph_hi = p + 1; hipLaunchKernelGGL(mk_fwd, dim3(grid), dim3(NWAVES * 64), LDS_BYTES, stream, a); }
#else
    a.ph_lo = 0; a.ph_hi = N_PHASES;
    hipLaunchKernelGGL(mk_fwd, dim3(grid), dim3(NWAVES * 64), LDS_BYTES, stream, a);
#endif
}
```

```cpp
#include <hip/hip_runtime.h>
#include <cstdio>
#include <cstdint>

constexpr int NB = 4, SEQ = 4096, DM = 2048, MTOK = NB * SEQ, FF = 5632, NH = 8, HD = 128, AW = 1024, SW = 1024;
constexpr int NG = 64, GP = 64, GH = 16, INW = 4096, NMOD = 9, MB = 256, NBLK = SEQ / MB, TOPK = 3;
constexpr float LN_EPS = 1e-5f, ALPHA = 1.189207115002721f, QSCALE = 0.08838834764831845f, LOG2E = 1.4426950408889634f, QS2 = QSCALE * LOG2E;

constexpr size_t MiB = 1u << 20;
constexpr size_t WS_CTL = 0, CTL_BYTES = 4 * MiB;
constexpr size_t WS_WGU1 = 6 * MiB, WS_WD1 = 50 * MiB, WS_WIN = 72 * MiB, WS_WGLU = 88 * MiB, WS_WOUT = 90 * MiB, WS_WGU2 = 98 * MiB, WS_WD2 = 142 * MiB;
constexpr size_t WS_A = 164 * MiB;
constexpr size_t WS_R = 228 * MiB;
constexpr size_t WS_H = 356 * MiB;
constexpr size_t WS_QKVU = WS_H, WS_YACT = WS_H + 128 * MiB;
constexpr size_t WS_SSMTAB = 4 * MiB;
constexpr size_t SSM_COEF = 0, SSM_BCAT = 65536, SSM_CCAT = 65536 + 262144;
constexpr size_t WS_SSP = 532 * MiB;
constexpr size_t SSP_SSS = 524288;
constexpr size_t WS_RSTAT = 534 * MiB;
constexpr size_t RS_SA = 524288, RS_SW = 786432;
constexpr size_t WS_SLOTS = 536 * MiB;
constexpr size_t WS_A2 = 292 * MiB;
constexpr size_t WS_END = 540 * MiB;
constexpr int CW_TMO = 0, CW_BAR = 4096, CW_LNC = 8192;
constexpr int CW_NMAX = 24576;
constexpr int CW_TICKET = 25600;
constexpr int CW_CMAX = 26624;
constexpr int CW_STATS1 = 65536, CW_STATS2 = CW_STATS1 + 2 * MTOK, CW_STATS3 = CW_STATS2 + 2 * MTOK, CW_SSA = CW_STATS3 + 2 * MTOK, CW_SSS = CW_SSA + MTOK;
constexpr int CW_MOD = CW_SSS + MTOK;
constexpr int CW_KMEAN = CW_MOD + NB * NMOD * DM;
constexpr int CW_SHADOW = 524288;
static_assert(CW_KMEAN + NB * NH * NBLK * HD <= CW_SHADOW && (size_t)(2 * CW_SHADOW) * 4 <= CTL_BYTES, "ctl");

constexpr int WAVETAB_LDS = 139264 + 448;
__device__ __forceinline__ int opaque_tid() {
    const unsigned slot = (unsigned)__builtin_amdgcn_s_getreg(((6 - 1) << 11) | (0 << 6) | 4) & 63u;
    const int wv = __builtin_amdgcn_readfirstlane((int)*(const volatile __attribute__((address_space(3))) unsigned char*)(unsigned)(WAVETAB_LDS + slot));
    int l; asm volatile("v_mbcnt_lo_u32_b32 %0, -1, 0\n\tv_mbcnt_hi_u32_b32 %0, -1, %0" : "=v"(l));
    return (wv << 6) | l;
}

namespace pg8 {
#define PG8_LAS __attribute__((address_space(3)))
typedef unsigned short bf16_t;
typedef short bf16x8 __attribute__((ext_vector_type(8)));
typedef float f32x4 __attribute__((ext_vector_type(4)));
typedef unsigned u32x4 __attribute__((ext_vector_type(4)));
constexpr int BM = 256, BK = 64, HALF = 128, HTB = HALF * BK * 2  , STAGE_BYTES = 8 * HTB, NXCD = 8, WGM = 8;

__host__ __device__ __forceinline__ int lds_byte(int r, int c) { const int st = (r >> 4) * 2 + (c >> 5), rr = r & 15, cc = c & 31, ob = rr * 64 + cc * 2; return st * 1024 + (ob ^ (((ob >> 9) & 1) << 5)); }
__host__ __device__ __forceinline__ void stage_rc(int b, int& R, int& C) { const int st = b / 1024, sb = b % 1024, swz = sb ^ (((sb >> 9) & 1) << 5); R = (st >> 1) * 16 + swz / 64; C = (st & 1) * 32 + (swz % 64) / 2; }
__host__ __device__ __forceinline__ int perm32(int rho) { const int n = rho >> 4, i = rho & 15; return 8 * (i >> 2) + 4 * n + (i & 3); }

struct Unit { int pm, pn; };
struct Gemm { const bf16_t* A; const bf16_t* Bt; int M, N, K; };

struct StaticOrder {
    int nM, nN, nwg, G, c, mul = 1;
    __host__ __device__ __forceinline__ void init(int M, int N, int G_, int c_) { nM = M / BM; nN = N / BM; nwg = nM * nN; G = G_; c = c_; }
    __host__ __device__ __forceinline__ bool next(int i, Unit& u) const {
        const long L = (long)(i / mul) * G + c; if (L >= nwg) return false;
        int wgid = (int)L; { const int q = nwg / NXCD, r = nwg % NXCD, xcd = wgid % NXCD, off = wgid / NXCD; wgid = (xcd < r ? xcd * (q + 1) : r * (q + 1) + (xcd - r) * q) + off; }
        const int nig = WGM * nN, gid = wgid / nig, fm = gid * WGM, gsz = (nM - fm) < WGM ? (nM - fm) : WGM;
        u.pm = fm + ((wgid % nig) % gsz); u.pn = (wgid % nig) / gsz; return true;
    }
    __device__ __forceinline__ void a_ready(const Unit&) const {}
    __device__ __forceinline__ void done(const Unit&) const {}
};

__device__ __forceinline__ unsigned cvt_pk_bf16(float lo, float hi) { unsigned r; asm volatile("v_cvt_pk_bf16_f32 %0, %1, %2" : "=v"(r) : "v"(lo), "v"(hi)); return r; }
typedef float f32x2 __attribute__((ext_vector_type(2)));
typedef int i32x8 __attribute__((ext_vector_type(8))); typedef int i32x4v __attribute__((ext_vector_type(4)));
__device__ __forceinline__ i32x8 pg8_cat8(bf16x8 lo, bf16x8 hi) { return __builtin_shufflevector(__builtin_bit_cast(i32x4v, lo), __builtin_bit_cast(i32x4v, hi), 0, 1, 2, 3, 4, 5, 6, 7); }
__device__ __forceinline__ unsigned cvt4_fp8(float a, float b, float c, float d) { int w = 0; w = __builtin_amdgcn_cvt_pk_fp8_f32(__builtin_amdgcn_fmed3f(a, -448.f, 448.f), __builtin_amdgcn_fmed3f(b, -448.f, 448.f), w, false);
    w = __builtin_amdgcn_cvt_pk_fp8_f32(__builtin_amdgcn_fmed3f(c, -448.f, 448.f), __builtin_amdgcn_fmed3f(d, -448.f, 448.f), w, true); return (unsigned)w; }
__device__ __forceinline__ float fsig(float v) { return __builtin_amdgcn_rcpf(1.f + __builtin_amdgcn_exp2f(-1.4426950408889634f * v)); }
__device__ __forceinline__ float bflo(unsigned w) { return __builtin_bit_cast(float, w << 16); }
__device__ __forceinline__ float bfhi(unsigned w) { return __builtin_bit_cast(float, w & 0xffff0000u); }

template <bool F8OUT> struct EpiSwiglu {
    static constexpr bool PERM = true, AFTER_DRAIN = false, HOOK = false;
    bf16_t* H;
    __device__ __forceinline__ void operator()(const f32x4 (&acc)[2][2][4][2], const Unit& u, int wr, int wc, int fr, int fq, int ui) const {
        const int row0 = u.pm * BM + wr * 64 + fr, col0 = u.pn * HALF + wc * 32 + 8 * fq;
#pragma unroll
        for (int ai = 0; ai < 2; ++ai)
#pragma unroll
            for (int m = 0; m < 4; ++m) { bf16_t* rowp = H + (size_t)(row0 + ai * HALF + m * 16) * FF + col0;
                const f32x4 g0 = acc[ai][0][m][0], g1 = acc[ai][0][m][1], u0 = acc[ai][1][m][0], u1 = acc[ai][1][m][1]; f32x4 v0, v1;
#pragma unroll
                for (int e = 0; e < 4; ++e) { v0[e] = g0[e] * fsig(g0[e]) * u0[e]; v1[e] = g1[e] * fsig(g1[e]) * u1[e]; }
                if constexpr (F8OUT) { typedef unsigned u32x2 __attribute__((ext_vector_type(2))); v0 = v0 * 4.f; v1 = v1 * 4.f;
                    *(u32x2*)((unsigned char*)H + (size_t)(row0 + ai * HALF + m * 16) * FF + col0) = (u32x2){cvt4_fp8(v0[0], v0[1], v0[2], v0[3]), cvt4_fp8(v1[0], v1[1], v1[2], v1[3])}; }
                else { u32x4 w; w.x = cvt_pk_bf16(v0[0], v0[1]); w.y = cvt_pk_bf16(v0[2], v0[3]); w.z = cvt_pk_bf16(v1[0], v1[1]); w.w = cvt_pk_bf16(v1[2], v1[3]);
                *(u32x4*)rowp = w; } }
    }
    __device__ __forceinline__ void hook(f32x4 (&)[2][2][4][2], int, int, int) const {}
};
template <bool F8OUT> struct EpiSwigluI8 {
    static constexpr bool PERM = true, AFTER_DRAIN = false, HOOK = false;
    bf16_t* H; const float* sA; const float* sW;
    __device__ __forceinline__ void operator()(const f32x4 (&acc)[2][2][4][2], const Unit& u, int wr, int wc, int fr, int fq, int ui) const {
        const int row0 = u.pm * BM + wr * 64 + fr, col0 = u.pn * HALF + wc * 32 + 8 * fq, wrow0 = u.pn * BM + wc * 32 + 8 * fq;
        f32x4 kx[2], kh[2];
#pragma unroll
        for (int n = 0; n < 2; ++n) { const f32x4 sg = *(const f32x4*)(sW + wrow0 + 4 * n), su = *(const f32x4*)(sW + wrow0 + HALF + 4 * n); kx[n] = sg * -1.4426950408889634f; kh[n] = sg * su * (F8OUT ? 4.f : 1.f); }
#pragma unroll
        for (int ai = 0; ai < 2; ++ai)
#pragma unroll
            for (int m = 0; m < 4; ++m) { const int row = row0 + ai * HALF + m * 16; const float sa = sA[row], sa2 = sa * sa; f32x4 v[2];
#pragma unroll
                for (int n = 0; n < 2; ++n) { const f32x4 ag4 = acc[ai][0][m][n], au4 = acc[ai][1][m][n];
#pragma unroll
                    for (int e = 0; e < 4; ++e) { const float ag = (float)__float_as_int(ag4[e]), au = (float)__float_as_int(au4[e]);
                        v[n][e] = (ag * au) * (sa2 * kh[n][e]) * __builtin_amdgcn_rcpf(1.f + __builtin_amdgcn_exp2f(ag * (sa * kx[n][e]))); } }
                if constexpr (F8OUT) { typedef unsigned u32x2 __attribute__((ext_vector_type(2)));
                    *(u32x2*)((unsigned char*)H + (size_t)row * FF + col0) = (u32x2){cvt4_fp8(v[0][0], v[0][1], v[0][2], v[0][3]), cvt4_fp8(v[1][0], v[1][1], v[1][2], v[1][3])}; }
                else { u32x4 w; w.x = cvt_pk_bf16(v[0][0], v[0][1]); w.y = cvt_pk_bf16(v[0][2], v[0][3]); w.z = cvt_pk_bf16(v[1][0], v[1][1]); w.w = cvt_pk_bf16(v[1][2], v[1][3]);
                    *(u32x4*)(H + (size_t)row * FF + col0) = w; } }
    }
    __device__ __forceinline__ void hook(f32x4 (&)[2][2][4][2], int, int, int) const {}
};
struct EpiQKVU {
    static constexpr bool PERM = true, AFTER_DRAIN = false, HOOK = false;
    bf16_t* O; float* kmean;
    __device__ __forceinline__ void operator()(const f32x4 (&acc)[2][2][4][2], const Unit& u, int wr, int wc, int fr, int fq, int ui) const {
        const int row0 = u.pm * BM + wr * 64 + fr, col0 = u.pn * BM + wc * 32 + 8 * fq;
        const float sc = (u.pn < 4) ? QS2 : 1.f;
#pragma unroll
        for (int ai = 0; ai < 2; ++ai)
#pragma unroll
            for (int m = 0; m < 4; ++m) { bf16_t* rowp = O + (size_t)(row0 + ai * HALF + m * 16) * INW + col0;
#pragma unroll
                for (int bj = 0; bj < 2; ++bj) { const f32x4 v0 = acc[ai][bj][m][0] * sc, v1 = acc[ai][bj][m][1] * sc;
                    u32x4 w; w.x = cvt_pk_bf16(v0[0], v0[1]); w.y = cvt_pk_bf16(v0[2], v0[3]); w.z = cvt_pk_bf16(v1[0], v1[1]); w.w = cvt_pk_bf16(v1[2], v1[3]);
                    *(u32x4*)(rowp + bj * HALF) = w; } }
        if (u.pn >= 4 && u.pn < 8) {
            const int b = u.pm >> 4, j = u.pm & 15;
#pragma unroll
            for (int bj = 0; bj < 2; ++bj)
#pragma unroll
                for (int n = 0; n < 2; ++n) { f32x4 s = (f32x4){0.f, 0.f, 0.f, 0.f};
#pragma unroll
                    for (int ai = 0; ai < 2; ++ai)
#pragma unroll
                        for (int m = 0; m < 4; ++m) s += acc[ai][bj][m][n];
#pragma unroll
                    for (int e = 0; e < 4; ++e) { float v = s[e]; v += __shfl_xor(v, 1); v += __shfl_xor(v, 2); v += __shfl_xor(v, 4); v += __shfl_xor(v, 8); s[e] = v; }
                    if (fr == 0) { const int ck = (u.pn - 4) * BM + bj * HALF + wc * 32 + 8 * fq + 4 * n, h = ck >> 7, d = ck & 127;
                        float* kp = kmean + ((size_t)((b * NH + h) * NBLK + j)) * HD + d;
#pragma unroll
                        for (int e = 0; e < 4; ++e) atomicAdd(kp + e, s[e] * (1.f / MB)); } }
        }
    }
    __device__ __forceinline__ void hook(f32x4 (&)[2][2][4][2], int, int, int) const {}
};
struct EpiGlu {
    static constexpr bool PERM = true, AFTER_DRAIN = false, HOOK = false;
    const bf16_t* Y; const float* bias; bf16_t* Amix; float* sss;
    __device__ __forceinline__ void operator()(const f32x4 (&acc)[2][2][4][2], const Unit& u, int wr, int wc, int fr, int fq, int ui) const {
        const int row0 = u.pm * BM + wr * 64 + fr, col0 = u.pn * BM + wc * 32 + 8 * fq;
        f32x4 bv[2][2];
#pragma unroll
        for (int bj = 0; bj < 2; ++bj)
#pragma unroll
            for (int n = 0; n < 2; ++n) bv[bj][n] = *(const f32x4*)(bias + col0 + bj * HALF + 4 * n);
#pragma unroll
        for (int ai = 0; ai < 2; ++ai)
#pragma unroll
            for (int m = 0; m < 4; ++m) { const int row = row0 + ai * HALF + m * 16; float ssq = 0.f;
#pragma unroll
                for (int bj = 0; bj < 2; ++bj) { const u32x4 yv = *(const u32x4*)(Y + (size_t)row * SW + col0 + bj * HALF);
                    const f32x4 a0 = acc[ai][bj][m][0] + bv[bj][0], a1 = acc[ai][bj][m][1] + bv[bj][1]; f32x4 z0, z1;
                    z0[0] = bflo(yv.x) * fsig(a0[0]); z0[1] = bfhi(yv.x) * fsig(a0[1]); z0[2] = bflo(yv.y) * fsig(a0[2]); z0[3] = bfhi(yv.y) * fsig(a0[3]);
                    z1[0] = bflo(yv.z) * fsig(a1[0]); z1[1] = bfhi(yv.z) * fsig(a1[1]); z1[2] = bflo(yv.w) * fsig(a1[2]); z1[3] = bfhi(yv.w) * fsig(a1[3]);
                    ssq += (z0[0] * z0[0] + z0[1] * z0[1]) + (z0[2] * z0[2] + z0[3] * z0[3]) + (z1[0] * z1[0] + z1[1] * z1[1]) + (z1[2] * z1[2] + z1[3] * z1[3]);
                    u32x4 w; w.x = cvt_pk_bf16(z0[0], z0[1]); w.y = cvt_pk_bf16(z0[2], z0[3]); w.z = cvt_pk_bf16(z1[0], z1[1]); w.w = cvt_pk_bf16(z1[2], z1[3]);
                    *(u32x4*)(Amix + (size_t)row * DM + AW + col0 + bj * HALF) = w; }
                ssq += __shfl_xor(ssq, 16); ssq += __shfl_xor(ssq, 32);
                if (fq == 0) sss[(size_t)row * 16 + u.pn * 4 + wc] = ssq; }
    }
    __device__ __forceinline__ void hook(f32x4 (&)[2][2][4][2], int, int, int) const {}
};
template <bool MIX, bool HALFG> struct EpiResid {
    static constexpr bool PERM = true, AFTER_DRAIN = false, HOOK = MIX;
    const float* xin; const bf16_t* R; bf16_t* Rout; bf16_t* Rdry; int mul; const float* stats_in  ; const float* lng; const float* lnb; const float* modgate  ; const PG8_LAS float* fac  ;
    const float* invmod  ;
    __device__ __forceinline__ void operator()(const f32x4 (&acc)[2][2][4][2], const Unit& u, int wr, int wc, int fr, int fq, int ui) const {
        const int row0 = u.pm * BM + wr * 64 + fr, col0 = u.pn * BM + wc * 32 + 8 * fq, b = u.pm >> 4; constexpr float gm = HALFG ? 0.5f : 1.0f;
        bf16_t* const Ro = (mul > 1 && (ui % mul) != mul - 1) ? Rdry : Rout;
        f32x4 gv[2][2], lg[2][2], lb[2][2];
#pragma unroll
        for (int bj = 0; bj < 2; ++bj)
#pragma unroll
            for (int n = 0; n < 2; ++n) { const int c = col0 + bj * HALF + 4 * n;
                gv[bj][n] = (*(const f32x4*)(modgate + (size_t)b * NMOD * DM + c) + 1.f) * gm;
                if (!xin) { if (invmod) { const f32x4 sh = *(const f32x4*)(invmod + (size_t)b * NMOD * DM + c), sc = *(const f32x4*)(invmod + (size_t)b * NMOD * DM + DM + c);
#pragma unroll
                        for (int e4 = 0; e4 < 4; ++e4) { const float iv = 1.f / (1.f + sc[e4]); lg[bj][n][e4] = iv; lb[bj][n][e4] = -sh[e4] * iv; } }
                    else if (lng) { lg[bj][n] = *(const f32x4*)(lng + c); lb[bj][n] = *(const f32x4*)(lnb + c); }
                    else { lg[bj][n] = (f32x4){1.f, 1.f, 1.f, 1.f}; lb[bj][n] = (f32x4){0.f, 0.f, 0.f, 0.f}; } } }
#pragma unroll
        for (int ai = 0; ai < 2; ++ai)
#pragma unroll
        for (int mp = 0; mp < 4; mp += 2) {
            f32x4 xr[2][2][2]; float mean[2], rstd[2];
#pragma unroll
            for (int mm = 0; mm < 2; ++mm) { const int row = row0 + ai * HALF + (mp + mm) * 16; const size_t off = (size_t)row * DM + col0;
                if (xin) {
#pragma unroll
                    for (int bj = 0; bj < 2; ++bj)
#pragma unroll
                        for (int n = 0; n < 2; ++n) xr[mm][bj][n] = *(const f32x4*)(xin + off + bj * HALF + 4 * n);
                } else { if (invmod || !stats_in) { mean[mm] = 0.f; rstd[mm] = 1.f; } else { mean[mm] = stats_in[2 * row]; rstd[mm] = stats_in[2 * row + 1]; }
#pragma unroll
                    for (int bj = 0; bj < 2; ++bj) { const u32x4 w = *(const u32x4*)(R + off + bj * HALF);
                        xr[mm][bj][0] = (f32x4){bflo(w.x), bfhi(w.x), bflo(w.y), bfhi(w.y)}; xr[mm][bj][1] = (f32x4){bflo(w.z), bfhi(w.z), bflo(w.w), bfhi(w.w)}; } } }
#pragma unroll
            for (int mm = 0; mm < 2; ++mm) { const int m = mp + mm, row = row0 + ai * HALF + m * 16; const size_t off = (size_t)row * DM + col0;
                float rm = 1.f; if (MIX) rm = fac[(2 + ui / mul) * BM + ai * HALF + wr * 64 + m * 16 + fr];
#pragma unroll
                for (int bj = 0; bj < 2; ++bj) { f32x4 o[2];
#pragma unroll
                    for (int n = 0; n < 2; ++n) { f32x4 xv = xr[mm][bj][n]; if (!xin) xv = (xv - mean[mm]) * rstd[mm] * lg[bj][n] + lb[bj][n];
                        o[n] = xv * ALPHA + gv[bj][n] * (acc[ai][bj][m][n] * rm); }
                    u32x4 w; w.x = cvt_pk_bf16(o[0][0], o[0][1]); w.y = cvt_pk_bf16(o[0][2], o[0][3]); w.z = cvt_pk_bf16(o[1][0], o[1][1]); w.w = cvt_pk_bf16(o[1][2], o[1][3]);
                    *(u32x4*)(Ro + off + bj * HALF) = w; } }
        }
    }
    __device__ __forceinline__ void hook(f32x4 (&acc)[2][2][4][2], int ui, int wr, int fr) const {
        if constexpr (MIX) {
#pragma unroll
            for (int ai = 0; ai < 2; ++ai)
#pragma unroll
                for (int m = 0; m < 4; ++m) { const float f = fac[(ui / mul) * BM + ai * HALF + wr * 64 + m * 16 + fr];
#pragma unroll
                    for (int bj = 0; bj < 2; ++bj)
#pragma unroll
                        for (int n = 0; n < 2; ++n) acc[ai][bj][m][n] *= f; }
        }
    }
};


template <class Epi, class Sched, bool ALIGN_EPI = false, bool SP2 = false, int F8SC = 0>
__device__ __forceinline__ void gemm_phase(PG8_LAS unsigned char* lds, const Gemm g, const Sched& S, const Epi& E) {
    const int tid = opaque_tid(), wid = __builtin_amdgcn_readfirstlane(tid >> 6), lane = tid & 63, wr = wid >> 2, wc = wid & 3, fr = lane & 15, fq = lane >> 4;
    const int K = g.K, nt = K / BK;
    unsigned voffA[2], voffB[2];
#pragma unroll
    for (int i = 0; i < 2; ++i) { int R, C; stage_rc(tid * 16 + i * 8192, R, C); const int Rb = Epi::PERM ? ((R & ~31) + perm32(R & 31)) : R;
        voffA[i] = (unsigned)(R * K + C) * 2u; voffB[i] = (unsigned)(Rb * K + C) * 2u; }
    const size_t kstep = (size_t)(BK * 2);
    const size_t hstep = (size_t)HALF * K * 2;
    const size_t tstep = 2 * hstep;
    const unsigned ldsw = (unsigned)wid * 1024u;
    const int aoff = lds_byte(wr * 64 + fr, fq * 8), boff = lds_byte(wc * 32 + fr, fq * 8);
#define PG8_SA(b, h) (((b) * 2 + (h)) * HTB)
#define PG8_SB(b, h) ((4 + (b) * 2 + (h)) * HTB)
#define PG8_STAGE(bufoff, gbase, voff) do { _Pragma("unroll") for (int _i = 0; _i < 2; ++_i) { unsigned _vo = (voff)[_i]; if constexpr (F8SC != 0) asm volatile("" : "+v"(_vo));     \
        __builtin_amdgcn_global_load_lds((const unsigned*)((const char*)(gbase) + _vo), (PG8_LAS unsigned*)(lds + (bufoff) + ldsw + _i * 8192), 16, 0, 0); } } while (0)
#define PG8_LDA(dst, b, h) do { _Pragma("unroll") for (int m = 0; m < 4; ++m) _Pragma("unroll") for (int k = 0; k < 2; ++k) dst[m][k] = *(const PG8_LAS bf16x8*)(lds + PG8_SA(b, h) + aoff + m * 2048 + k * 1024); } while (0)
#define PG8_LDB(dst, b, h) do { _Pragma("unroll") for (int n = 0; n < 2; ++n) _Pragma("unroll") for (int k = 0; k < 2; ++k) dst[n][k] = *(const PG8_LAS bf16x8*)(lds + PG8_SB(b, h) + boff + n * 2048 + k * 1024); } while (0)
#define PG8_MMA(ai, bj, At, Bt) do { __builtin_amdgcn_s_setprio(1); _Pragma("unroll") for (int m = 0; m < 4; ++m) _Pragma("unroll") for (int n = 0; n < 2; ++n) { \
        if constexpr (F8SC > 0) acc[ai][bj][m][n] = __builtin_amdgcn_mfma_scale_f32_16x16x128_f8f6f4(pg8_cat8(Bt[n][0], Bt[n][1]), pg8_cat8(At[m][0], At[m][1]), acc[ai][bj][m][n], 0, 0, 0, 0x7f7f7f7f, 0, F8SC * 0x01010101); \
        else if constexpr (F8SC < 0) { _Pragma("unroll") for (int k = 0; k < 2; ++k) acc[ai][bj][m][n] = __builtin_bit_cast(f32x4, __builtin_amdgcn_mfma_i32_16x16x64_i8(__builtin_bit_cast(i32x4v, Bt[n][k]), __builtin_bit_cast(i32x4v, At[m][k]), __builtin_bit_cast(i32x4v, acc[ai][bj][m][n]), 0, 0, 0)); }         else { _Pragma("unroll") for (int k = 0; k < 2; ++k) acc[ai][bj][m][n] = __builtin_amdgcn_mfma_f32_16x16x32_bf16(Bt[n][k], At[m][k], acc[ai][bj][m][n], 0, 0, 0); } } __builtin_amdgcn_s_setprio(0); } while (0)
#define PG8_WAIT_V(n) asm volatile("s_waitcnt vmcnt(" #n ")" ::: "memory")
#define PG8_WAIT_L(n) asm volatile("s_waitcnt lgkmcnt(" #n ")" ::: "memory")
#define PG8_BAR __builtin_amdgcn_s_barrier()
#define PG8_SCHED __builtin_amdgcn_sched_barrier(0)
    Unit cur, nxt; int ui = 0;
    if (!S.next(0, cur)) return;
    f32x4 acc[2][2][4][2];
#pragma unroll
    for (int a = 0; a < 2; ++a)
#pragma unroll
        for (int b = 0; b < 2; ++b)
#pragma unroll
            for (int m = 0; m < 4; ++m)
#pragma unroll
                for (int n = 0; n < 2; ++n) acc[a][b][m][n] = (f32x4){0.f, 0.f, 0.f, 0.f};
    bf16x8 At[4][2], B0[2][2], B1[2][2];
    const char* cA = (const char*)g.A + (size_t)cur.pm * tstep; const char* cB = (const char*)g.Bt + (size_t)cur.pn * tstep;
    S.a_ready(cur);
    if constexpr (SP2) {
        PG8_STAGE(PG8_SB(0, 0), cB, voffB); PG8_STAGE(PG8_SB(0, 1), cB + hstep, voffB); PG8_STAGE(PG8_SA(0, 0), cA, voffA); PG8_STAGE(PG8_SA(0, 1), cA + hstep, voffA);
        if (wr == 1) PG8_BAR;
        PG8_WAIT_V(2); PG8_BAR;
        PG8_STAGE(PG8_SB(1, 0), cB + kstep, voffB); PG8_STAGE(PG8_SA(1, 0), cA + kstep, voffA); PG8_STAGE(PG8_SB(1, 1), cB + hstep + kstep, voffB);
        PG8_WAIT_V(6); PG8_BAR;
    } else {
        PG8_STAGE(PG8_SB(0, 0), cB, voffB); PG8_STAGE(PG8_SA(0, 0), cA, voffA); PG8_STAGE(PG8_SB(0, 1), cB + hstep, voffB); PG8_STAGE(PG8_SA(0, 1), cA + hstep, voffA);
        if (wr == 1) PG8_BAR;
        PG8_WAIT_V(4); PG8_BAR;
        PG8_STAGE(PG8_SB(1, 0), cB + kstep, voffB); PG8_STAGE(PG8_SA(1, 0), cA + kstep, voffA); PG8_STAGE(PG8_SB(1, 1), cB + hstep + kstep, voffB);
        PG8_WAIT_V(6); PG8_BAR;
    }
    for (;;) {
        { int tq_ = tid; asm volatile("" : "+v"(tq_));
#pragma unroll
          for (int i = 0; i < 2; ++i) { int R, C; stage_rc(tq_ * 16 + i * 8192, R, C); const int Rb = Epi::PERM ? ((R & ~31) + perm32(R & 31)) : R;
              voffA[i] = (unsigned)(R * K + C) * 2u; voffB[i] = (unsigned)(Rb * K + C) * 2u; } }
        const bool has_next = S.next(ui + 1, nxt);
        const char* nA = has_next ? (const char*)g.A + (size_t)nxt.pm * tstep : cA; const char* nB = has_next ? (const char*)g.Bt + (size_t)nxt.pn * tstep : cB;
        for (int t = 0; t < nt; t += 2) {
            const bool last = (t == nt - 2);
            const char* a1 = cA + (size_t)(t + 1) * kstep;
            const char* a2 = last ? nA : cA + (size_t)(t + 2) * kstep; const char* b2 = last ? nB : cB + (size_t)(t + 2) * kstep;
            const char* a3 = a2 + kstep; const char* b3 = b2 + kstep;
            if (last && has_next) S.a_ready(nxt);
            if constexpr (Epi::HOOK) { if (t == (nt >> 1)) E.hook(acc, ui, wr, fr); }
            if constexpr (SP2) {
            PG8_LDB(B0, 0, 0); PG8_LDB(B1, 0, 1); PG8_SCHED; PG8_LDA(At, 0, 0); PG8_STAGE(PG8_SA(1, 1), a1 + hstep, voffA);
            PG8_WAIT_V(8); PG8_WAIT_L(0); PG8_BAR; PG8_MMA(0, 0, At, B0); PG8_MMA(0, 1, At, B1); PG8_BAR; PG8_SCHED;
            PG8_LDA(At, 0, 1); PG8_STAGE(PG8_SB(0, 0), b2, voffB); PG8_STAGE(PG8_SB(0, 1), b2 + hstep, voffB); PG8_STAGE(PG8_SA(0, 0), a2, voffA);
            PG8_WAIT_V(8); PG8_WAIT_L(0); PG8_BAR; PG8_MMA(1, 0, At, B0); PG8_MMA(1, 1, At, B1); PG8_BAR; PG8_SCHED;
            PG8_LDB(B0, 1, 0); PG8_LDB(B1, 1, 1); PG8_SCHED; PG8_LDA(At, 1, 0); PG8_STAGE(PG8_SA(0, 1), a2 + hstep, voffA);
            PG8_WAIT_V(8); PG8_WAIT_L(0); PG8_BAR; PG8_MMA(0, 0, At, B0); PG8_MMA(0, 1, At, B1); PG8_BAR; PG8_SCHED;
            PG8_LDA(At, 1, 1); PG8_STAGE(PG8_SB(1, 0), b3, voffB); PG8_STAGE(PG8_SB(1, 1), b3 + hstep, voffB); PG8_STAGE(PG8_SA(1, 0), a3, voffA);
            PG8_WAIT_V(8); PG8_WAIT_L(0); PG8_BAR; PG8_MMA(1, 0, At, B0); PG8_MMA(1, 1, At, B1); PG8_BAR; PG8_SCHED;
            } else {
            PG8_LDB(B0, 0, 0); PG8_SCHED; PG8_LDA(At, 0, 0); PG8_STAGE(PG8_SA(1, 1), a1 + hstep, voffA);
            PG8_WAIT_L(8); PG8_BAR; PG8_WAIT_L(0); PG8_MMA(0, 0, At, B0); PG8_BAR; PG8_SCHED;
            PG8_LDB(B1, 0, 1); PG8_STAGE(PG8_SB(0, 0), b2, voffB);
            PG8_BAR; PG8_WAIT_L(0); PG8_MMA(0, 1, At, B1); PG8_BAR;
            PG8_LDA(At, 0, 1); PG8_STAGE(PG8_SA(0, 0), a2, voffA);
            PG8_BAR; PG8_WAIT_L(0); PG8_MMA(1, 0, At, B0); PG8_BAR; PG8_SCHED;
            PG8_STAGE(PG8_SB(0, 1), b2 + hstep, voffB);
            PG8_WAIT_V(6); PG8_BAR; PG8_MMA(1, 1, At, B1); PG8_BAR;
            PG8_LDB(B0, 1, 0); PG8_SCHED; PG8_LDA(At, 1, 0); PG8_STAGE(PG8_SA(0, 1), a2 + hstep, voffA);
            PG8_WAIT_L(8); PG8_BAR; PG8_WAIT_L(0); PG8_MMA(0, 0, At, B0); PG8_BAR; PG8_SCHED;
            PG8_LDB(B1, 1, 1); PG8_STAGE(PG8_SB(1, 0), b3, voffB);
            PG8_BAR; PG8_WAIT_L(0); PG8_MMA(0, 1, At, B1); PG8_BAR;
            PG8_LDA(At, 1, 1); PG8_STAGE(PG8_SA(1, 0), a3, voffA);
            PG8_BAR; PG8_WAIT_L(0); PG8_MMA(1, 0, At, B0); PG8_BAR; PG8_SCHED;
            PG8_STAGE(PG8_SB(1, 1), b3 + hstep, voffB);
            PG8_WAIT_V(6); PG8_BAR; PG8_MMA(1, 1, At, B1); PG8_BAR;
            }
        }
        if constexpr (ALIGN_EPI) { if (wr == 0) PG8_BAR; }
        if constexpr (!Epi::AFTER_DRAIN) { { const int l2_ = opaque_tid() & 63; E(acc, cur, wr, wc, l2_ & 15, l2_ >> 4, ui); }     S.done(cur); }
        if (!has_next) break;
#pragma unroll
        for (int a = 0; a < 2; ++a)
#pragma unroll
            for (int b = 0; b < 2; ++b)
#pragma unroll
                for (int m = 0; m < 4; ++m)
#pragma unroll
                    for (int n = 0; n < 2; ++n) acc[a][b][m][n] = (f32x4){0.f, 0.f, 0.f, 0.f};
        cur = nxt; cA = nA; cB = nB; ++ui;
        if constexpr (ALIGN_EPI) { if (wr == 1) PG8_BAR; }
    }
    PG8_WAIT_V(0);
    if constexpr (!ALIGN_EPI) { if (wr == 0) PG8_BAR; }
    PG8_BAR;
    if constexpr (Epi::AFTER_DRAIN) { E.fused(acc, cur, wr, wc, fr, fq, lds, wid, lane); S.done(cur); }
#undef PG8_SA
#undef PG8_SB
#undef PG8_STAGE
#undef PG8_LDA
#undef PG8_LDB
#undef PG8_MMA
#undef PG8_WAIT_V
#undef PG8_WAIT_L
#undef PG8_BAR
#undef PG8_SCHED
}
}

#define GAS __attribute__((address_space(1)))
#define LAS __attribute__((address_space(3)))
typedef unsigned short bf16;
typedef unsigned v4u __attribute__((ext_vector_type(4)));
typedef float f32x4 __attribute__((ext_vector_type(4)));
typedef short bf16x8 __attribute__((ext_vector_type(8)));
typedef GAS unsigned gu32;
typedef GAS unsigned long long gu64;
#define RLX_AGENT __ATOMIC_RELAXED, __HIP_MEMORY_SCOPE_AGENT
#define LDS_WAIT() asm volatile("s_waitcnt lgkmcnt(0)" ::: "memory")
#define VM_WAIT() asm volatile("s_waitcnt vmcnt(0)" ::: "memory")
__device__ __forceinline__ unsigned long long rt() { return __builtin_amdgcn_s_memrealtime(); }
__device__ __forceinline__ unsigned f2bf(float f) { unsigned u = __builtin_bit_cast(unsigned, f); return (u + 0x7fffu + ((u >> 16) & 1u)) >> 16; }
__device__ __forceinline__ unsigned pk2(float lo, float hi) { return f2bf(lo) | (f2bf(hi) << 16); }
#define XB_TMO      128
#define XB_XCNT(j)  (256  + 64 * (j))
#define XB_XSUB(j)  (1280 + 64 * (j))
#define XB_XGEN(j)  (2304 + 64 * (j))
#define XB_TOP      3328
#define XB_TOPGEN   3392
#define XCD_BAR_WORDS 3456
#define XB_SPIN_CAP (1u << 18)

__device__ __forceinline__ unsigned xb_ld(unsigned* p)              { return __hip_atomic_load(p, __ATOMIC_RELAXED, __HIP_MEMORY_SCOPE_AGENT); }
__device__ __forceinline__ unsigned xb_add(unsigned* p, unsigned v) { return __hip_atomic_fetch_add(p, v, __ATOMIC_RELAXED, __HIP_MEMORY_SCOPE_AGENT); }
__device__ __forceinline__ unsigned xb_xcc_id() { return (unsigned)__builtin_amdgcn_s_getreg((3 << 11) | 20) & 0xFu; }
#define XB_SPIN(cond, bar) do { unsigned _sp = 0; while (cond) { __builtin_amdgcn_s_sleep(1); \
    if ((++_sp & 255u) == 0u) { if (xb_ld(&(bar)[XB_TMO])) break; if (_sp > XB_SPIN_CAP) { atomicAdd(&(bar)[XB_TMO], 1u); break; } } } } while (0)

struct XcdBarrier {
    unsigned* bar; unsigned x;
    volatile LAS unsigned* st;
};

__device__ __forceinline__ XcdBarrier xcd_barrier_post(unsigned* bar, volatile LAS unsigned* st) {
    XcdBarrier b; b.bar = bar; b.x = xb_xcc_id(); b.st = st;
    if (threadIdx.x == 0) (void)xb_add(&bar[XB_XCNT(b.x)], 1u);
    return b;
}
__device__ __forceinline__ void xcd_barrier_complete(unsigned* bar, unsigned x, unsigned& nloc, unsigned& nx) {
    const unsigned G = gridDim.x * gridDim.y * gridDim.z;
    unsigned sum, cnt, mine, sp = 0u;
    for (;;) {
        sum = 0u; cnt = 0u; mine = 0u;
#pragma unroll
        for (unsigned j = 0; j < 16; ++j) { const unsigned c = xb_ld(&bar[XB_XCNT(j)]); sum += c; cnt += (c > 0u) ? 1u : 0u; mine = (j == x) ? c : mine; }
        if (sum == G) break;
        __builtin_amdgcn_s_sleep(1);
        if ((++sp & 255u) == 0u) { if (xb_ld(&bar[XB_TMO])) break; if (sp > XB_SPIN_CAP) { atomicAdd(&bar[XB_TMO], 1u); break; } }
    }
    nloc = mine > 0u ? mine : 1u; nx = cnt > 0u ? cnt : 1u;
}

__device__ __forceinline__ void xcd_barrier(const XcdBarrier& b) {
    asm volatile("s_waitcnt vmcnt(0)" ::: "memory");
    __syncthreads();
    if (threadIdx.x == 0) {
        unsigned* bar = b.bar;
        __builtin_amdgcn_s_waitcnt(0);
        unsigned nloc = b.st[0], nx = b.st[1];
        if (nloc == 0u) { xcd_barrier_complete(bar, b.x, nloc, nx); b.st[0] = nloc; b.st[1] = nx; }
        const unsigned old = xb_add(&bar[XB_XSUB(b.x)], 1u);
        const unsigned gen = old / nloc;
        if (old + 1u == (gen + 1u) * nloc) {
            __builtin_amdgcn_fence(__ATOMIC_RELEASE, "agent");
            asm volatile("s_waitcnt vmcnt(0)" ::: "memory");
            const unsigned og = xb_add(&bar[XB_TOP], 1u);
            const unsigned tg = og / nx;
            if (og + 1u == (tg + 1u) * nx) xb_add(&bar[XB_TOPGEN], 1u);
            else XB_SPIN(xb_ld(&bar[XB_TOPGEN]) == tg, bar);
            __builtin_amdgcn_fence(__ATOMIC_ACQUIRE, "agent");
            xb_add(&bar[XB_XGEN(b.x)], 1u);
            asm volatile("s_waitcnt vmcnt(0)" ::: "memory");
        } else {
            XB_SPIN(xb_ld(&bar[XB_XGEN(b.x)]) == gen, bar);
            __builtin_amdgcn_fence(__ATOMIC_ACQUIRE, "agent");
            asm volatile("s_waitcnt vmcnt(0)" ::: "memory");
        }
    }
    __syncthreads();
}

namespace moba {
typedef short bf16x8 __attribute__((ext_vector_type(8)));
typedef short s16x4 __attribute__((ext_vector_type(4)));
typedef float f32x16 __attribute__((ext_vector_type(16)));
typedef float f32x4 __attribute__((ext_vector_type(4)));
typedef unsigned u32x4 __attribute__((ext_vector_type(4)));
typedef unsigned short bf16e;
constexpr int D = 128, NW = 8, QBLK = 32, KVBLK = 64, QB = NW * QBLK, LP = INW  , OP = DM  ;
constexpr int SHM_V = KVBLK * D * 2, SHM_K = KVBLK * D * 2;
constexpr int LDS_BYTES = 2 * SHM_V + 2 * SHM_K + NW * 64 * 4;
constexpr float THR2 = 11.0f;
#define KSWZ(row, colB) ((row) * 256 + ((colB) ^ (((row) & 7) << 4)))
#define SBAR() __builtin_amdgcn_sched_barrier(0)
__device__ __forceinline__ int v_st(int k, int c) { const int kk = (k & ~0xC) | ((k & 4) << 1) | ((k & 8) >> 1); return ((kk >> 3) * 4 + (c >> 5)) * 512 + ((kk & 7) * 32 + (c & 31)) * 2; }
__device__ __forceinline__ int v_rd_base(int lane) { return ((lane & 3) << 3) | (((lane >> 2) & 3) << 6) | (((lane >> 4) & 1) << 5) | (((lane >> 5) & 1) << 8); }
constexpr int v_rd_off(int d0, int ks, int half) { return d0 * 512 + ks * 4096 + half * 2048; }
__device__ __forceinline__ int crow(int r, int hi) { return (r & 3) + 8 * (r >> 2) + 4 * hi; }
__device__ __forceinline__ unsigned cvtpk(float lo, float hi) { unsigned r; asm volatile("v_cvt_pk_bf16_f32 %0, %1, %2" : "=v"(r) : "v"(lo), "v"(hi)); return r; }
__device__ __forceinline__ bf16x8 load8(const bf16e* p) { return *reinterpret_cast<const bf16x8*>(p); }
__device__ __forceinline__ void mask_tile(f32x16& p0, f32x16& p1, int dq) {
    const float NEG = -__builtin_inff();
#pragma unroll
    for (int r = 0; r < 16; ++r) { const int c = (r & 3) + 8 * (r >> 2); if (dq - c < 0) p0[r] = NEG; if (dq - c - 32 < 0) p1[r] = NEG; }
}
__device__ __forceinline__ void partialSM(f32x16& p0, f32x16& p1, float& m_reg, float& mn, float& alpha) {
    float pmax = p0[0];
#pragma unroll
    for (int r = 1; r < 16; ++r) pmax = fmaxf(pmax, p0[r]);
#pragma unroll
    for (int r = 0; r < 16; ++r) pmax = fmaxf(pmax, p1[r]);
    { auto rr = __builtin_amdgcn_permlane32_swap(__float_as_uint(pmax), __float_as_uint(pmax), false, false); pmax = fmaxf(__uint_as_float(rr[0]), __uint_as_float(rr[1])); }
    if (__builtin_expect(__all((pmax - m_reg) <= THR2), 1)) { mn = m_reg; alpha = 1.f; }
    else { mn = fmaxf(m_reg, pmax); alpha = __builtin_amdgcn_exp2f(m_reg - mn); m_reg = mn; }
#pragma unroll
    for (int r = 0; r < 16; ++r) p0[r] = p0[r] - mn;
#pragma unroll
    for (int r = 0; r < 16; ++r) p1[r] = p1[r] - mn;
#pragma unroll
    for (int r = 0; r < 16; ++r) p0[r] = __builtin_amdgcn_exp2f(p0[r]);
}
__device__ __forceinline__ void finishSM(f32x16& p0, f32x16& p1, float alpha, float& l_reg, bf16x8& pa0, bf16x8& pa1, bf16x8& pa2, bf16x8& pa3) {
#pragma unroll
    for (int r = 0; r < 16; ++r) p1[r] = __builtin_amdgcn_exp2f(p1[r]);
    float ps = 0;
#pragma unroll
    for (int r = 0; r < 16; ++r) ps += p0[r];
#pragma unroll
    for (int r = 0; r < 16; ++r) ps += p1[r];
    { auto rr = __builtin_amdgcn_permlane32_swap(__float_as_uint(ps), __float_as_uint(ps), false, false); ps = __uint_as_float(rr[0]) + __uint_as_float(rr[1]); }
    l_reg = l_reg * alpha + ps;
#define PK4(P, B_, OUT) do { unsigned a0 = cvtpk(P[B_+0], P[B_+1]), a1 = cvtpk(P[B_+2], P[B_+3]);                          \
        unsigned b0 = cvtpk(P[B_+4], P[B_+5]), b1 = cvtpk(P[B_+6], P[B_+7]);                                             \
        auto r0 = __builtin_amdgcn_permlane32_swap(a0, b0, false, false); auto r1 = __builtin_amdgcn_permlane32_swap(a1, b1, false, false); \
        u32x4 w = {r0[0], r1[0], r0[1], r1[1]}; OUT = *reinterpret_cast<bf16x8*>(&w); } while (0)
    PK4(p0, 0, pa0); PK4(p0, 8, pa1); PK4(p1, 0, pa2); PK4(p1, 8, pa3);
#undef PK4
}
template <int KB>
__device__ __forceinline__ void qkt(f32x16& p0, f32x16& p1, const char* K_lds, int r32, int hi, const bf16x8* qr, float bt, float sl2) {
#pragma unroll
    for (int r = 0; r < 16; ++r) { const int c = (r & 3) + 8 * (r >> 2); p0[r] = __builtin_fmaf(sl2, (float)c, bt); p1[r] = __builtin_fmaf(sl2, (float)(c + 32), bt); }
    const char* kb[4];
#pragma unroll
    for (int dd = 0; dd < 4; ++dd) kb[dd] = K_lds + KB * SHM_K + KSWZ(r32, (dd * 16 + hi * 8) * 2);
#pragma unroll
    for (int d0 = 0; d0 < 8; ++d0) { const char* a = kb[d0 & 3] + (d0 >> 2) * 128;
        bf16x8 b0 = *reinterpret_cast<const bf16x8*>(a);
        bf16x8 b1 = *reinterpret_cast<const bf16x8*>(a + 32 * 256);
        p0 = __builtin_amdgcn_mfma_f32_32x32x16_bf16(b0, qr[d0], p0, 0, 0, 0);
        p1 = __builtin_amdgcn_mfma_f32_32x32x16_bf16(b1, qr[d0], p1, 0, 0, 0); }
}
template <int VB>
__device__ __forceinline__ void pv_tile(f32x16* o, int vb0, bf16x8 pa0, bf16x8 pa1, bf16x8 pa2, bf16x8 pa3) {
#define TRRD(dst, off) asm volatile("ds_read_b64_tr_b16 %0, %1 offset:%2" : "=&v"(dst) : "v"(vb0), "i"(off) : "memory")
#define PV_D0(d0) do { s16x4 l0, l1, l2, l3, h0, h1, h2, h3; constexpr int b_ = VB * SHM_V + v_rd_off(d0, 0, 0); \
        TRRD(l0, b_); TRRD(h0, b_ + 2048); TRRD(l1, b_ + 4096); TRRD(h1, b_ + 6144); TRRD(l2, b_ + 8192); TRRD(h2, b_ + 10240); TRRD(l3, b_ + 12288); TRRD(h3, b_ + 14336); \
        asm volatile("s_waitcnt lgkmcnt(0)" ::: "memory"); SBAR();   \
        o[d0] = __builtin_amdgcn_mfma_f32_32x32x16_bf16(pa0, (bf16x8){l0[0], l0[1], l0[2], l0[3], h0[0], h0[1], h0[2], h0[3]}, o[d0], 0, 0, 0);   \
        o[d0] = __builtin_amdgcn_mfma_f32_32x32x16_bf16(pa1, (bf16x8){l1[0], l1[1], l1[2], l1[3], h1[0], h1[1], h1[2], h1[3]}, o[d0], 0, 0, 0);   \
        o[d0] = __builtin_amdgcn_mfma_f32_32x32x16_bf16(pa2, (bf16x8){l2[0], l2[1], l2[2], l2[3], h2[0], h2[1], h2[2], h2[3]}, o[d0], 0, 0, 0);   \
        o[d0] = __builtin_amdgcn_mfma_f32_32x32x16_bf16(pa3, (bf16x8){l3[0], l3[1], l3[2], l3[3], h3[0], h3[1], h3[2], h3[3]}, o[d0], 0, 0, 0); } while (0)
    PV_D0(0); PV_D0(1); PV_D0(2); PV_D0(3);
#undef PV_D0
#undef TRRD
}
struct BlockRef { const bf16e* Q; const bf16e* K; const bf16e* V; bf16e* O; const float* km; float* ssa; int ib; float sl2; };
struct Seam { bf16x8 qr[8]; bf16x8 st_v0, st_v1, st_k0, st_k1; };
#define ROW(p, k0, rr) ((p) + (size_t)((k0) + (rr)) * LP + sc)
#define VMW() asm volatile("s_waitcnt vmcnt(0)" ::: "memory")
#define VMWN(n) asm volatile("s_waitcnt vmcnt(%0)" :: "i"(n) : "memory")
#define SLOAD_H(Kp, Vp, k0) do { S.st_v0 = load8(ROW(Vp, k0, sr)); S.st_v1 = load8(ROW(Vp, k0, 32 + sr)); S.st_k0 = load8(ROW(Kp, k0, sr)); S.st_k1 = load8(ROW(Kp, k0, 32 + sr)); } while (0)
#define SWRITE_HK(bf) do { *(bf16x8*)(K_lds + (bf) * SHM_K + kws) = S.st_k0; *(bf16x8*)(K_lds + (bf) * SHM_K + kws + 32 * 256) = S.st_k1; } while (0)
#define SWRITE_HV(bf) do { *(bf16x8*)(V_lds + (bf) * SHM_V + vst0) = S.st_v0; *(bf16x8*)(V_lds + (bf) * SHM_V + vst1) = S.st_v1; } while (0)
#define SWRITE_H(bf) do { SWRITE_HV(bf); SWRITE_HK(bf); } while (0)
__device__ __forceinline__ void prime(const BlockRef& cur, char* lds, Seam& S) {
    const int tid = opaque_tid(), wid = __builtin_amdgcn_readfirstlane(tid >> 6), lane = tid & 63, r32 = lane & 31, hi = lane >> 5;
    const int sr = tid >> 4, sc = (tid & 15) * 8, kws = KSWZ(sr, sc * 2); char* K_lds = lds + 2 * SHM_V;
#pragma unroll
    for (int d0 = 0; d0 < 8; ++d0) S.qr[d0] = load8(cur.Q + (size_t)(wid * QBLK + r32) * LP + d0 * 16 + hi * 8);
    S.st_k0 = load8(ROW(cur.K, 0, sr)); S.st_k1 = load8(ROW(cur.K, 0, 32 + sr)); VMW(); SWRITE_HK(0);
    __syncthreads();
}
__device__ __forceinline__ void block(const BlockRef& cur, const BlockRef& nxt, char* lds, Seam& S) {
    const int tid = opaque_tid(), wid = __builtin_amdgcn_readfirstlane(tid >> 6), lane = tid & 63, r32 = lane & 31, hi = lane >> 5;
    const int P0 = cur.ib * QB, NT = 4 * (cur.ib + 1);
    const int qlo = P0 + wid * QBLK, qm = qlo + r32 - 4 * hi;
    char* V_lds = lds; char* K_lds = lds + 2 * SHM_V;
    float* ws = (float*)(lds + 2 * SHM_V + 2 * SHM_K) + wid * 64; float* li_l = ws, * al_l = ws + 32;
    float m_reg = -1e30f, l_reg = 0; f32x16 o[4] = {};
    const int sr = tid >> 4, sc = (tid & 15) * 8, vst0 = v_st(sr, sc), vst1 = v_st(32 + sr, sc), kws = KSWZ(sr, sc * 2);
    const int vb0 = (int)(uintptr_t)V_lds + v_rd_base(lane);
    const bf16e* Kh = cur.K; const bf16e* Vh = cur.V;
    const float sl2 = cur.sl2;
    S.st_v0 = load8(ROW(Vh, 0, sr)); S.st_v1 = load8(ROW(Vh, 0, 32 + sr));
    unsigned selmask;
    {
        { const int j = sr & 15; const float* kmr = cur.km + j * D + sc; const f32x4 a = *(const f32x4*)kmr, b = *(const f32x4*)(kmr + 4);
          u32x4 hw = {cvtpk(a[0], a[1]), cvtpk(a[2], a[3]), cvtpk(b[0], b[1]), cvtpk(b[2], b[3])};
          if (sr >= 16) { float rsd[8];
#pragma unroll
              for (int e = 0; e < 4; ++e) { const unsigned w = hw[e]; rsd[2 * e] = (e < 2 ? a[2 * e] : b[2 * e - 4]) - __builtin_bit_cast(float, w << 16); rsd[2 * e + 1] = (e < 2 ? a[2 * e + 1] : b[2 * e - 3]) - __builtin_bit_cast(float, w & 0xffff0000u); }
              hw = (u32x4){cvtpk(rsd[0], rsd[1]), cvtpk(rsd[2], rsd[3]), cvtpk(rsd[4], rsd[5]), cvtpk(rsd[6], rsd[7])}; }
          *(u32x4*)(K_lds + SHM_K + kws) = hw; }
        __syncthreads();
        f32x16 g = {};
        const char* kb[4];
#pragma unroll
        for (int dd = 0; dd < 4; ++dd) kb[dd] = K_lds + SHM_K + KSWZ(r32, (dd * 16 + hi * 8) * 2);
#pragma unroll
        for (int d0 = 0; d0 < 8; ++d0) { const bf16x8 b0 = *reinterpret_cast<const bf16x8*>(kb[d0 & 3] + (d0 >> 2) * 128); g = __builtin_amdgcn_mfma_f32_32x32x16_bf16(b0, S.qr[d0], g, 0, 0, 0); }
        float gv[16];
#pragma unroll
        for (int r8 = 0; r8 < 8; ++r8) { const float s = g[r8] + g[r8 + 8];
            auto rr = __builtin_amdgcn_permlane32_swap(__float_as_uint(s), __float_as_uint(s), false, false);
            const int j0 = (r8 & 3) + 8 * (r8 >> 2); gv[j0] = __uint_as_float(rr[0]); gv[j0 + 4] = __uint_as_float(rr[1]); }
        const float NEG = -__builtin_inff();
#pragma unroll
        for (int j = 0; j < 16; ++j) if (j >= cur.ib) gv[j] = NEG;
        selmask = 0u;
#pragma unroll
        for (int rep = 0; rep < 3; ++rep) { float best = NEG; int bi = 0;
#pragma unroll
            for (int j = 0; j < 16; ++j) if (gv[j] > best) { best = gv[j]; bi = j; }
            if (best > NEG) selmask |= 1u << bi;
#pragma unroll
            for (int j = 0; j < 16; ++j) if (j == bi) gv[j] = NEG; }
        selmask |= 1u << cur.ib;
        __syncthreads();
    }
#define RESC(a) do { if (__any((a) < 1.f)) { if (hi == 0) al_l[r32] = (a); asm volatile("s_waitcnt lgkmcnt(0)" ::: "memory");              \
                     for (int d_ = 0; d_ < 4; ++d_) for (int r = 0; r < 16; ++r) o[d_][r] *= al_l[crow(r, hi)]; } } while (0)
#define KBASE(t) ((t) * KVBLK)
#define BT(t) (((selmask >> ((t) >> 2)) & 1u) ? sl2 * (float)(KBASE(t) - P0 + 4 * hi) : -__builtin_inff())
#define MASKT(P0_, P1_, t) do { const int kb_ = KBASE(t); if (kb_ + KVBLK - 1 > qlo) mask_tile(P0_, P1_, qm - kb_); } while (0)
    constexpr int NQL = 8;
#define SEAM_K0() do { VMWN(NQL); SWRITE_HK(0); SBAR(); } while (0)
    f32x16 pA0, pA1, pB0, pB1; float mnA, mnB, alA, alB; bf16x8 pa0, pa1, pa2, pa3;
    VMW(); SWRITE_HV(0); SBAR();
    SLOAD_H(Kh, Vh, KBASE(1));
    SBAR(); qkt<0>(pA0, pA1, K_lds, r32, hi, S.qr, BT(0), sl2);
    MASKT(pA0, pA1, 0); partialSM(pA0, pA1, m_reg, mnA, alA);
    VMW(); SWRITE_H(1);
    __syncthreads();
#define HALF_STEP(PX0, PX1, mnX, alX, PY0, PY1, alY, t, KB, VB, SB) do {                                                      \
        SBAR(); qkt<KB>(PX0, PX1, K_lds, r32, hi, S.qr, BT(t), sl2);                                                          \
        finishSM(PY0, PY1, alY, l_reg, pa0, pa1, pa2, pa3); SBAR();                                                           \
        if ((t) + 1 < NT) { SLOAD_H(Kh, Vh, KBASE((t) + 1)); SBAR(); }                                                        \
        pv_tile<VB>(o, vb0, pa0, pa1, pa2, pa3); MASKT(PX0, PX1, (t)); partialSM(PX0, PX1, m_reg, mnX, alX);                  \
        __syncthreads();                                                                                                      \
        if ((t) + 1 < NT) { VMW(); SWRITE_H(SB); }                                                                            \
        RESC(alX); __syncthreads(); } while (0)
    for (int t = 1; t + 1 < NT; t += 2) {
        HALF_STEP(pB0, pB1, mnB, alB, pA0, pA1, alA, t, 1, 0, 0);
        HALF_STEP(pA0, pA1, mnA, alA, pB0, pB1, alB, t + 1, 0, 1, 1);
    }
    SBAR(); qkt<1>(pB0, pB1, K_lds, r32, hi, S.qr, BT(NT - 1), sl2); SBAR();
    S.st_k0 = load8(ROW(nxt.K, 0, sr)); S.st_k1 = load8(ROW(nxt.K, 0, 32 + sr)); SBAR();
#pragma unroll
    for (int d0 = 0; d0 < 8; ++d0) S.qr[d0] = load8(nxt.Q + (size_t)(wid * QBLK + r32) * LP + d0 * 16 + hi * 8);
    SBAR();
    finishSM(pA0, pA1, alA, l_reg, pa0, pa1, pa2, pa3); SBAR();
    pv_tile<0>(o, vb0, pa0, pa1, pa2, pa3);
    MASKT(pB0, pB1, NT - 1); partialSM(pB0, pB1, m_reg, mnB, alB); __syncthreads(); RESC(alB);
    finishSM(pB0, pB1, alB, l_reg, pa0, pa1, pa2, pa3); SBAR(); pv_tile<1>(o, vb0, pa0, pa1, pa2, pa3);
    SBAR(); SEAM_K0();
    if (hi == 0) li_l[r32] = l_reg; asm volatile("s_waitcnt lgkmcnt(0)" ::: "memory");
    float rli[16];
#pragma unroll
    for (int r = 0; r < 16; ++r) rli[r] = __builtin_amdgcn_rcpf(li_l[crow(r, hi)]);
    bf16e* Ow = cur.O + (size_t)(wid * QBLK) * OP;
#pragma unroll
    for (int r = 0; r < 16; ++r) { const int orow = crow(r, hi); float ssq = 0.f;
#pragma unroll
        for (int d0 = 0; d0 < 4; ++d0) { const float v = o[d0][r] * rli[r]; ssq += v * v;
            const float vn = __shfl_xor(v, 1);
            if ((r32 & 1) == 0) *(unsigned*)(Ow + (size_t)orow * OP + d0 * 32 + r32) = cvtpk(v, vn); }
        ssq += __shfl_xor(ssq, 1); ssq += __shfl_xor(ssq, 2); ssq += __shfl_xor(ssq, 4); ssq += __shfl_xor(ssq, 8); ssq += __shfl_xor(ssq, 16);
        if (r32 == 0) cur.ssa[(size_t)(wid * QBLK + orow) * NH] = ssq; }
    __syncthreads();
#undef RESC
#undef KBASE
#undef BT
#undef MASKT
#undef SEAM_K0
#undef HALF_STEP
}
#undef ROW
#undef VMW
#undef VMWN
#undef SLOAD_H
#undef SWRITE_HK
#undef SWRITE_HV
#undef SWRITE_H
#undef KSWZ
#undef SBAR
}

constexpr int NWAVES = 8;
constexpr int RING_OFF = 0, RING_BYTES = 131072;
constexpr int FAC_OFF = 135168;
constexpr int LDSCTL_OFF = FAC_OFF + 4096, MISC_OFF = LDSCTL_OFF + 320;
constexpr int LDS_BYTES = 147456;
static_assert(MISC_OFF + 128 <= LDSCTL_OFF + 448 && WAVETAB_LDS == LDSCTL_OFF + 448 && WAVETAB_LDS + 64 <= LDS_BYTES, "LDS map");
#ifndef I8_GU1
#define I8_GU1 1
#endif
#ifndef I8_GU2
#define I8_GU2 1
#endif
#ifndef I8_GU
#define I8_GU (I8_GU1 || I8_GU2)
#endif
#ifndef F8_DOWN1
#define F8_DOWN1 1
#endif
#ifndef F8_DOWN2
#define F8_DOWN2 1
#endif
#ifndef MK_PER_PHASE
#define MK_PER_PHASE 0
#endif
constexpr int N_PHASES = 13;

__device__ __forceinline__ float wave_sum(float v) {
#pragma unroll
    for (int o = 1; o < 64; o <<= 1) v += __shfl_xor(v, o);
    return v;
}
__device__ __forceinline__ float fsigm(float v) { return __builtin_amdgcn_rcpf(1.f + __builtin_amdgcn_exp2f(-LOG2E * v)); }
__device__ __forceinline__ float bf2f(unsigned h) { return __builtin_bit_cast(float, h << 16); }
__device__ __forceinline__ float gelu_tanh(float v) { const float u = 0.7978845608028654f * (v + 0.044715f * v * v * v); return v * fsigm(2.f * u); }

__device__ __forceinline__ void p0_transpose_item(const float* W, int K, int N, bf16* WT, int mode, const float* ks, LAS float* scr, int item, int lane) {
    const int nblk = N / 32, kb = item / nblk, nb = item % nblk, k0 = 64 * kb, n0 = 32 * nb;
    const int drow0 = (mode == 0) ? n0 : (256 * (n0 >> 7) + (n0 & 127) + (mode == 2 ? 128 : 0));
    float tv[32];
#pragma unroll
    for (int i = 0; i < 32; ++i) tv[i] = W[(size_t)(k0 + 2 * i + (lane >> 5)) * N + n0 + (lane & 31)];
#pragma unroll
    for (int i = 0; i < 32; ++i) { const int kk = 2 * i + (lane >> 5); float v = tv[i]; if (ks) v *= ks[k0 + kk]; scr[kk * 33 + (lane & 31)] = v; }
    LDS_WAIT(); asm volatile("" ::: "memory");
    const int c = lane & 7;
#pragma unroll
    for (int j = 0; j < 4; ++j) { const int n = (lane >> 3) + 8 * j; const LAS float* s = scr + (8 * c) * 33 + n;
        v4u o; o.x = pk2(s[0 * 33], s[1 * 33]); o.y = pk2(s[2 * 33], s[3 * 33]); o.z = pk2(s[4 * 33], s[5 * 33]); o.w = pk2(s[6 * 33], s[7 * 33]);
        *(GAS v4u*)(WT + (size_t)(drow0 + n) * K + k0 + 8 * c) = o; }
    LDS_WAIT(); asm volatile("" ::: "memory");
}

__device__ __forceinline__ void p0_transpose_item8(const float* W, int K, int N, unsigned char* WT8, float wscale, LAS float* scr, int item, int lane) {
    const int nblk = N / 32, kb = item / nblk, nb = item % nblk, k0 = 64 * kb, n0 = 32 * nb;
    float tv[32];
#pragma unroll
    for (int i = 0; i < 32; ++i) tv[i] = W[(size_t)(k0 + 2 * i + (lane >> 5)) * N + n0 + (lane & 31)];
#pragma unroll
    for (int i = 0; i < 32; ++i) scr[(2 * i + (lane >> 5)) * 33 + (lane & 31)] = tv[i] * wscale;
    LDS_WAIT(); asm volatile("" ::: "memory");
    const int c = lane & 7; typedef unsigned u32x2 __attribute__((ext_vector_type(2)));
#pragma unroll
    for (int j = 0; j < 4; ++j) { const int n = (lane >> 3) + 8 * j; const LAS float* s = scr + (8 * c) * 33 + n;
        *(GAS u32x2*)(WT8 + (size_t)(n0 + n) * K + k0 + 8 * c) = (u32x2){pg8::cvt4_fp8(s[0 * 33], s[1 * 33], s[2 * 33], s[3 * 33]), pg8::cvt4_fp8(s[4 * 33], s[5 * 33], s[6 * 33], s[7 * 33])}; }
    LDS_WAIT(); asm volatile("" ::: "memory");
}

__device__ __forceinline__ void p0_transpose_item_i8(const float* W, int K, int N, signed char* WT8, int mode, const unsigned* cmax, float* sW, LAS float* scr, int item, int lane) {
    const int nblk = N / 32, kb = item / nblk, nb = item % nblk, k0 = 64 * kb, n0 = 32 * nb;
    const int drow0 = 256 * (n0 >> 7) + (n0 & 127) + (mode == 2 ? 128 : 0);
    float tv[32];
#pragma unroll
    for (int i = 0; i < 32; ++i) tv[i] = W[(size_t)(k0 + 2 * i + (lane >> 5)) * N + n0 + (lane & 31)];
#pragma unroll
    for (int i = 0; i < 32; ++i) scr[(2 * i + (lane >> 5)) * 33 + (lane & 31)] = tv[i];
    LDS_WAIT(); asm volatile("" ::: "memory");
    const int c = lane & 7; typedef unsigned u32x2 __attribute__((ext_vector_type(2)));
#pragma unroll
    for (int j = 0; j < 4; ++j) { const int n = (lane >> 3) + 8 * j; const LAS float* s = scr + (8 * c) * 33 + n;
        const float cm = __uint_as_float(__hip_atomic_load(cmax + drow0 + n, __ATOMIC_RELAXED, __HIP_MEMORY_SCOPE_AGENT)), inv = cm > 0.f ? 127.f / cm : 0.f;
        int q[8];
#pragma unroll
        for (int e = 0; e < 8; ++e) q[e] = (int)__builtin_rintf(s[e * 33] * inv) & 0xff;
        *(GAS u32x2*)(WT8 + (size_t)(drow0 + n) * K + k0 + 8 * c) = (u32x2){(unsigned)(q[0] | (q[1] << 8) | (q[2] << 16) | (q[3] << 24)), (unsigned)(q[4] | (q[5] << 8) | (q[6] << 16) | (q[7] << 24))};
        if (kb == 0 && c == 0) sW[drow0 + n] = cm * (1.f / 127.f); }
    LDS_WAIT(); asm volatile("" ::: "memory");
}
__device__ __forceinline__ void p0_colmax_item(const float* W, int N, int mode, unsigned* cmax, int item, int lane) {
    const int ncg = N / 256, cg = item % ncg, kc = item / ncg, n = cg * 256 + 4 * lane;
    f32x4 mx = {0.f, 0.f, 0.f, 0.f};
#pragma unroll 16
    for (int k = 32 * kc; k < 32 * kc + 32; ++k) { const f32x4 w = *(const GAS f32x4*)(W + (size_t)k * N + n); mx[0] = fmaxf(mx[0], fabsf(w[0])); mx[1] = fmaxf(mx[1], fabsf(w[1])); mx[2] = fmaxf(mx[2], fabsf(w[2])); mx[3] = fmaxf(mx[3], fabsf(w[3])); }
    const int drow = 256 * (n >> 7) + (n & 127) + (mode == 2 ? 128 : 0);
#pragma unroll
    for (int e = 0; e < 4; ++e) atomicMax(cmax + drow + e, __float_as_uint(mx[e]));
}

template <bool LN, int OUT, bool SRCBF>
__device__ __forceinline__ void row_phase(const void* src, float* rstat, const float* g, const float* bta, const float* mod, int ishift, bf16* A, float* out, float* sA, bf16* xcopy, int gw, int NGW, int lane) {
    asm volatile("" : "+v"(lane));
    f32x4 v[4][2], nv[4][2];
#define RP_LOAD(dst, m_) do { _Pragma("unroll") for (int j = 0; j < 4; ++j) { \
        if (SRCBF) { const v4u w = *((const GAS v4u*)((const bf16*)src + (size_t)(m_) * DM) + lane + 64 * j); \
            dst[j][0] = (f32x4){bf2f(w.x & 0xffffu), bf2f(w.x >> 16), bf2f(w.y & 0xffffu), bf2f(w.y >> 16)}; dst[j][1] = (f32x4){bf2f(w.z & 0xffffu), bf2f(w.z >> 16), bf2f(w.w & 0xffffu), bf2f(w.w >> 16)}; } \
        else { const GAS f32x4* p = (const GAS f32x4*)((const float*)src + (size_t)(m_) * DM) + 2 * (lane + 64 * j); dst[j][0] = p[0]; dst[j][1] = p[1]; } } } while (0)
    if (gw < MTOK) RP_LOAD(v, gw);
    for (int m = gw; m < MTOK; m += NGW) {
        const int b = m >> 12;
        const f32x4* msh = (const f32x4*)(mod + (size_t)b * NMOD * DM + (size_t)ishift * DM) + 2 * lane; const f32x4* msc = msh + DM / 4;
        const f32x4* gp = (const f32x4*)g + 2 * lane; const f32x4* bp = (const f32x4*)bta + 2 * lane;
        if (m + NGW < MTOK) RP_LOAD(nv, m + NGW);
        float mean = 0.f, rstd = 1.f;
        if (LN) { float s = 0.f;
#pragma unroll
            for (int j = 0; j < 4; ++j)
#pragma unroll
                for (int h = 0; h < 2; ++h) s += (v[j][h][0] + v[j][h][1]) + (v[j][h][2] + v[j][h][3]);
            mean = wave_sum(s) * (1.f / DM); float q = 0.f;
#pragma unroll
            for (int j = 0; j < 4; ++j)
#pragma unroll
                for (int h = 0; h < 2; ++h) { const f32x4 d = v[j][h] - mean; q += (d[0] * d[0] + d[1] * d[1]) + (d[2] * d[2] + d[3] * d[3]); }
            rstd = rsqrtf(wave_sum(q) * (1.f / DM) + LN_EPS);
            if (rstat && lane == 0) { rstat[2 * m] = mean; rstat[2 * m + 1] = rstd; } }
        float amax = 0.f;
#pragma unroll
        for (int j = 0; j < 4; ++j) { f32x4 pre[2];
#pragma unroll
            for (int h = 0; h < 2; ++h) { f32x4 t = v[j][h];
                if (LN) t = (t - mean) * rstd * gp[128 * j + h] + bp[128 * j + h];
                pre[h] = t;
                if (OUT == 0) { ((GAS f32x4*)(out + (size_t)m * DM) + 2 * (lane + 64 * j))[h] = t; }
                else { t = t * (msc[128 * j + h] + 1.f) + msh[128 * j + h];
                    if (OUT == 2) amax = fmaxf(amax, fmaxf(fmaxf(fabsf(t[0]), fabsf(t[1])), fmaxf(fabsf(t[2]), fabsf(t[3])))); }
                v[j][h] = t; }
            if (OUT != 0 && xcopy) { v4u w; w.x = pk2(pre[0][0], pre[0][1]); w.y = pk2(pre[0][2], pre[0][3]); w.z = pk2(pre[1][0], pre[1][1]); w.w = pk2(pre[1][2], pre[1][3]); *((GAS v4u*)(xcopy + (size_t)m * DM) + lane + 64 * j) = w; }
            if (OUT == 1) { const f32x4 t0 = v[j][0], t1 = v[j][1]; v4u w; w.x = pk2(t0[0], t0[1]); w.y = pk2(t0[2], t0[3]); w.z = pk2(t1[0], t1[1]); w.w = pk2(t1[2], t1[3]);
                *((GAS v4u*)(A + (size_t)m * DM) + lane + 64 * j) = w; }
        }
        if (OUT == 2) {
#pragma unroll
            for (int o = 1; o < 64; o <<= 1) amax = fmaxf(amax, __shfl_xor(amax, o));
            const float inv = amax > 0.f ? 127.f / amax : 0.f; if (lane == 0) sA[m] = amax * (1.f / 127.f);
            typedef unsigned u32x2 __attribute__((ext_vector_type(2)));
#pragma unroll
            for (int j = 0; j < 4; ++j) { int q[8];
#pragma unroll
                for (int e = 0; e < 8; ++e) q[e] = (int)__builtin_rintf(v[j][e >> 2][e & 3] * inv) & 0xff;
                *((GAS u32x2*)((unsigned char*)A + (size_t)m * DM) + lane + 64 * j) = (u32x2){(unsigned)(q[0] | (q[1] << 8) | (q[2] << 16) | (q[3] << 24)), (unsigned)(q[4] | (q[5] << 8) | (q[6] << 16) | (q[7] << 24))}; }
        }
#pragma unroll
        for (int j = 0; j < 4; ++j) { v[j][0] = nv[j][0]; v[j][1] = nv[j][1]; }
    }
#undef RP_LOAD
}

__device__ __forceinline__ void attn_query(const bf16* QKVU, const float* kmean, bf16* Amix, float* ssa, int idx, LAS float* scr, int lane) {
    LAS float* sq = scr; LAS float* sp = scr + 256;
    const int t = idx % SEQ, bh = idx / SEQ, b = bh / NH, h = bh % NH, qb = t / MB;
    const float slope2 = __builtin_amdgcn_exp2f(-(float)(h + 1)) * LOG2E;
    const size_t rowq = (size_t)(b * SEQ + t);
    sq[lane] = bf2f(QKVU[rowq * INW + h * HD + lane]); sq[lane + 64] = bf2f(QKVU[rowq * INW + h * HD + lane + 64]);
    LDS_WAIT(); asm volatile("" ::: "memory");
    float gate = 0.f;
    if (lane < NBLK) { const float* km = kmean + ((size_t)bh * NBLK + lane) * HD; for (int d = 0; d < HD; ++d) gate += sq[d] * km[d]; }
    unsigned mask = 0u;
    for (int r = 0; r < TOPK; ++r) {
        const bool cand = (lane < qb) && !((mask >> lane) & 1u);
        const float v = cand ? gate : -INFINITY; float mxv = v;
        mxv = fmaxf(mxv, __shfl_xor(mxv, 8)); mxv = fmaxf(mxv, __shfl_xor(mxv, 4)); mxv = fmaxf(mxv, __shfl_xor(mxv, 2)); mxv = fmaxf(mxv, __shfl_xor(mxv, 1));
        const unsigned long long bal = __ballot(cand && v == mxv) & 0xFFFFull;
        if (bal) mask |= 1u << __builtin_ctzll(bal);
    }
    mask |= 1u << qb;
    float mx = -1e30f; int ns = 0;
    for (int j = 0; j <= qb; ++j) { if (!((mask >> j) & 1u)) continue;
        for (int kk = lane; kk < MB; kk += 64) {
            const int kp = j * MB + kk; float sc = -1e30f;
            if (kp <= t) { const v4u* kr = (const v4u*)(QKVU + (size_t)(b * SEQ + kp) * INW + AW + h * HD); float a = 0.f;
                for (int d8 = 0; d8 < HD / 8; ++d8) { const v4u w = kr[d8]; const LAS float* q8 = sq + 8 * d8;
                    a += q8[0] * bf2f(w.x & 0xffffu) + q8[1] * bf2f(w.x >> 16) + q8[2] * bf2f(w.y & 0xffffu) + q8[3] * bf2f(w.y >> 16)
                       + q8[4] * bf2f(w.z & 0xffffu) + q8[5] * bf2f(w.z >> 16) + q8[6] * bf2f(w.w & 0xffffu) + q8[7] * bf2f(w.w >> 16); }
                sc = a - slope2 * (float)(t - kp); }
            sp[ns * MB + kk] = sc; mx = fmaxf(mx, sc); }
        ++ns; }
    for (int o = 32; o > 0; o >>= 1) mx = fmaxf(mx, __shfl_xor(mx, o));
    float sum = 0.f;
    for (int i = lane; i < ns * MB; i += 64) { const float p = __builtin_amdgcn_exp2f(sp[i] - mx); sp[i] = p; sum += p; }
    sum = wave_sum(sum);
    LDS_WAIT(); asm volatile("" ::: "memory");
    float o0 = 0.f, o1 = 0.f; int s = 0;
    for (int j = 0; j <= qb; ++j) { if (!((mask >> j) & 1u)) continue;
        for (int kk = 0; kk < MB; ++kk) { const int kp = j * MB + kk; if (kp > t) break;
            const float p = sp[s * MB + kk]; const unsigned vv = *(const unsigned*)(QKVU + (size_t)(b * SEQ + kp) * INW + 2 * AW + h * HD + 2 * lane);
            o0 += p * bf2f(vv & 0xffffu); o1 += p * bf2f(vv >> 16); }
        ++s; }
    const float inv = 1.f / sum; o0 *= inv; o1 *= inv;
    *(unsigned*)(Amix + rowq * DM + h * HD + 2 * lane) = pk2(o0, o1);
    const float ss = wave_sum(o0 * o0 + o1 * o1);
    if (lane == 0) atomicAdd(ssa + rowq, ss);
    LDS_WAIT(); asm volatile("" ::: "memory");
}
__device__ __forceinline__ void ssm_unit(const bf16* QKVU, const float* lam_re, const float* lam_im, const float* log_dt, const float* b_re, const float* b_im,
                                         const float* c_re, const float* c_im, const float* dsk, bf16* Yact, int b, int g, LAS float* xs, int p) {
    const float dt = expf(log_dt[g]), lr = lam_re[g * GP + p], li = lam_im[g * GP + p], dec = expf(lr * dt);
    const float ar = dec * cosf(li * dt), ai = dec * sinf(li * dt), den = lr * lr + li * li;
    const float cr = ((ar - 1.f) * lr + ai * li) / den, ci = (ai * lr - (ar - 1.f) * li) / den;
    float bbr[GH], bbi[GH];
#pragma unroll
    for (int hh = 0; hh < GH; ++hh) { const float br = b_re[((size_t)g * GP + p) * GH + hh], bi = b_im[((size_t)g * GP + p) * GH + hh]; bbr[hh] = cr * br - ci * bi; bbi[hh] = cr * bi + ci * br; }
    float xr = 0.f, xi = 0.f;
    for (int t = 0; t < SEQ; ++t) {
        const bf16* ur = QKVU + (size_t)(b * SEQ + t) * INW + 3 * AW + g * GH; float br = 0.f, bi = 0.f;
        const v4u u0 = *(const v4u*)ur, u1 = *(const v4u*)(ur + 8);
        const unsigned uw[8] = {u0.x, u0.y, u0.z, u0.w, u1.x, u1.y, u1.z, u1.w};
#pragma unroll
        for (int hh = 0; hh < 8; ++hh) { const float ua = bf2f(uw[hh] & 0xffffu), ub = bf2f(uw[hh] >> 16); br += bbr[2 * hh] * ua + bbr[2 * hh + 1] * ub; bi += bbi[2 * hh] * ua + bbi[2 * hh + 1] * ub; }
        const float nr = ar * xr - ai * xi + br, ni = ar * xi + ai * xr + bi; xr = nr; xi = ni;
        asm volatile("" ::: "memory"); xs[p] = xr; xs[64 + p] = xi; LDS_WAIT(); asm volatile("" ::: "memory");
        if (p < GH) { float y = 0.f; for (int q = 0; q < GP; ++q) y += xs[q] * c_re[((size_t)g * GH + p) * GP + q] - xs[64 + q] * c_im[((size_t)g * GH + p) * GP + q];
            y += dsk[g * GH + p] * bf2f(ur[p]); Yact[(size_t)(b * SEQ + t) * SW + g * GH + p] = (bf16)f2bf(gelu_tanh(y)); }
        LDS_WAIT(); asm volatile("" ::: "memory");
    }
}


#ifndef PROBE_MASK
#define PROBE_MASK 0
#endif
#define NREP15 (((PROBE_MASK >> 15) & 1) ? 2 : 1)
namespace s5 {
typedef short bf16x8 __attribute__((ext_vector_type(8)));
typedef float f32x16 __attribute__((ext_vector_type(16)));
typedef float f32x2 __attribute__((ext_vector_type(2)));
constexpr int ROWB = 528, WREG = 32 * ROWB, XCH_OFF = 8 * WREG;
static_assert(XCH_OFF == FAC_OFF, "LDS map: S5 wave regions end where the exchange area starts");
__device__ __forceinline__ unsigned cvtpk(float lo, float hi) { unsigned r; asm volatile("v_cvt_pk_bf16_f32 %0, %1, %2" : "=v"(r) : "v"(lo), "v"(hi)); return r; }
__device__ __forceinline__ bf16x8 pack8(const float* v) { v4u w = {cvtpk(v[0], v[1]), cvtpk(v[2], v[3]), cvtpk(v[4], v[5]), cvtpk(v[6], v[7])}; return __builtin_bit_cast(bf16x8, w); }
template <bool FULL>
__device__ __forceinline__ void pass(const bf16* ubase, bf16* ybase, LAS unsigned char* reg, const bf16x8 (&bfr)[4], const bf16x8 (&cfr)[5], float ar, float ai, float& xr, float& xi, int lane) {
    const int j32 = lane & 31, hi = lane >> 5, i16 = lane & 15, q4 = lane >> 4;
    bf16x8 u0 = *(const bf16x8*)(ubase + (size_t)(j32) * INW + 8 * hi), u1 = *(const bf16x8*)(ubase + (size_t)(32 + j32) * INW + 8 * hi);
    bf16x8 u2 = *(const bf16x8*)(ubase + (size_t)(64 + j32) * INW + 8 * hi);
    for (int sc = 0; sc < 16; ++sc) {
        const bf16x8 ua = u0; u0 = u1; u1 = u2;
        if (sc + 3 < 16) u2 = *(const bf16x8*)(ubase + (size_t)(32 * (sc + 3) + j32) * INW + 8 * hi);
        const f32x16 z = {};
#pragma unroll
        for (int nb = 0; nb < 4; ++nb) {
            const f32x16 d = __builtin_amdgcn_mfma_f32_32x32x16_bf16(bfr[nb], ua, z, 0, 0, 0);
#pragma unroll
            for (int q = 0; q < 4; ++q) *(LAS f32x4*)(reg + j32 * ROWB + (32 * nb + 4 * hi + 8 * q) * 4) = (f32x4){d[4 * q], d[4 * q + 1], d[4 * q + 2], d[4 * q + 3]}; }
        asm volatile("s_waitcnt lgkmcnt(0)" ::: "memory");
#pragma unroll
        for (int t8 = 0; t8 < 32; t8 += 8) {
            f32x2 bu[8];
#pragma unroll
            for (int k = 0; k < 8; ++k) bu[k] = *(const LAS f32x2*)(reg + (t8 + k) * ROWB + 8 * lane);
#pragma unroll
            for (int k = 0; k < 8; ++k) { const float nr = __builtin_fmaf(ar, xr, __builtin_fmaf(-ai, xi, bu[k].x)), ni = __builtin_fmaf(ar, xi, __builtin_fmaf(ai, xr, bu[k].y)); xr = nr; xi = ni;
                if (FULL) *(LAS unsigned*)(reg + (t8 + k) * ROWB + 4 * lane) = cvtpk(xr, xi); }
        }
        if (FULL) {
            *(LAS bf16x8*)(reg + j32 * ROWB + 256 + 16 * hi) = ua;
            asm volatile("s_waitcnt lgkmcnt(0)" ::: "memory");
#pragma unroll
            for (int rb = 0; rb < 2; ++rb) { f32x4 y = {0.f, 0.f, 0.f, 0.f};
#pragma unroll
                for (int kc = 0; kc < 4; ++kc) { const bf16x8 a = *(const LAS bf16x8*)(reg + (16 * rb + i16) * ROWB + 64 * kc + 16 * q4); y = __builtin_amdgcn_mfma_f32_16x16x32_bf16(a, cfr[kc], y, 0, 0, 0); }
                { const bf16x8 a = *(const LAS bf16x8*)(reg + (16 * rb + i16) * ROWB + 256 + 16 * (q4 & 1)); y = __builtin_amdgcn_mfma_f32_16x16x32_bf16(a, cfr[4], y, 0, 0, 0); }
#pragma unroll
                for (int e = 0; e < 4; ++e) { const int tok = 32 * sc + 16 * rb + 4 * q4 + e; ybase[(size_t)tok * SW + i16] = (bf16)f2bf(gelu_tanh(y[e])); } }
            asm volatile("s_waitcnt lgkmcnt(0)" ::: "memory");
        }
    }
}
__device__ __forceinline__ void tables(const float* lam_re, const float* lam_im, const float* log_dt, const float* b_re, const float* b_im, const float* c_re, const float* c_im, unsigned char* tab, int g, int p) {
    const float dt = expf(log_dt[g]), lr = lam_re[g * GP + p], li = lam_im[g * GP + p], dec = expf(lr * dt), ar = dec * cosf(li * dt), ai = dec * sinf(li * dt), den = lr * lr + li * li;
    const float d512 = expf(512.f * lr * dt), ang = 512.f * li * dt;
    *(f32x4*)(tab + SSM_COEF + ((size_t)g * GP + p) * 16) = (f32x4){ar, ai, d512 * cosf(ang), d512 * sinf(ang)};
    const float cr = ((ar - 1.f) * lr + ai * li) / den, ci = (ai * lr - (ar - 1.f) * li) / den;
    const float* br = b_re + ((size_t)g * GP + p) * GH; const float* bi = b_im + ((size_t)g * GP + p) * GH;
    float vr[16], vi[16];
#pragma unroll
    for (int e = 0; e < 16; ++e) { vr[e] = cr * br[e] - ci * bi[e]; vi[e] = cr * bi[e] + ci * br[e]; }
    bf16x8* dre = (bf16x8*)(tab + SSM_BCAT + ((size_t)g * 128 + 2 * p) * GH * 2); bf16x8* dim = (bf16x8*)(tab + SSM_BCAT + ((size_t)g * 128 + 2 * p + 1) * GH * 2);
    dre[0] = pack8(vr); dre[1] = pack8(vr + 8); dim[0] = pack8(vi); dim[1] = pack8(vi + 8);
#pragma unroll
    for (int o = 0; o < GH; ++o) *(unsigned*)(tab + SSM_CCAT + (((size_t)g * GH + o) * 128 + 2 * p) * 2) = cvtpk(c_re[((size_t)g * GH + o) * GP + p], -c_im[((size_t)g * GH + o) * GP + p]);
}
__device__ __forceinline__ void unit(const bf16* QKVU, const unsigned char* tab, const float* dsk, bf16* Yact, int b, int g, LAS unsigned char* lds) {
    const int tid = opaque_tid(), lane = tid & 63, w = __builtin_amdgcn_readfirstlane(tid >> 6);
    const int j32 = lane & 31, hi = lane >> 5, i16 = lane & 15, q4 = lane >> 4;
    const f32x4 cf = *(const f32x4*)(tab + SSM_COEF + ((size_t)g * GP + lane) * 16);
    const float ar = cf[0], ai = cf[1], Ar = cf[2], Ai = cf[3];
    bf16x8 bfr[4], cfr[5];
#pragma unroll
    for (int nb = 0; nb < 4; ++nb) bfr[nb] = *(const bf16x8*)(tab + SSM_BCAT + (((size_t)g * 128 + 32 * nb + j32) * GH + 8 * hi) * 2);
#pragma unroll
    for (int kc = 0; kc < 4; ++kc) cfr[kc] = *(const bf16x8*)(tab + SSM_CCAT + (((size_t)g * GH + i16) * 128 + 32 * kc + 8 * q4) * 2);
    { float v[8];
#pragma unroll
      for (int e = 0; e < 8; ++e) v[e] = (q4 < 2 && 8 * q4 + e == i16) ? dsk[g * GH + i16] : 0.f;
      cfr[4] = pack8(v); }
    const bf16* ubase = QKVU + (size_t)(b * SEQ + 512 * w) * INW + 3 * AW + GH * g;
    bf16* ybase = Yact + (size_t)(b * SEQ + 512 * w) * SW + GH * g;
    LAS unsigned char* reg = lds + w * WREG;
    LAS f32x2* xch = (LAS f32x2*)(lds + XCH_OFF);
    float xr = 0.f, xi = 0.f;
    for (int r15 = 0; r15 < NREP15; ++r15) { xr = 0.f; xi = 0.f; pass<false>(ubase, ybase, reg, bfr, cfr, ar, ai, xr, xi, lane); }
    xch[w * 64 + lane] = (f32x2){xr, xi};
    __syncthreads();
    xr = 0.f; xi = 0.f;
    for (int v = 0; v < w; ++v) { const f32x2 e = xch[v * 64 + lane]; const float nr = Ar * xr - Ai * xi + e.x, ni = Ar * xi + Ai * xr + e.y; xr = nr; xi = ni; }
    pass<true>(ubase, ybase, reg, bfr, cfr, ar, ai, xr, xi, lane);
    __syncthreads();
}
}
__device__ __forceinline__ moba::BlockRef attn_ref(const bf16* QKVU, bf16* Amix, const float* kmean, float* ssa, int pi, int which) {
    const int bh = pi >> 3, s = pi & 7, b = bh / NH, h = bh % NH, ib = which ? s : 15 - s;
    moba::BlockRef r;
    r.Q = QKVU + (size_t)(b * SEQ + ib * MB) * INW + h * HD; r.K = QKVU + (size_t)(b * SEQ) * INW + AW + h * HD; r.V = QKVU + (size_t)(b * SEQ) * INW + 2 * AW + h * HD;
    r.O = Amix + (size_t)(b * SEQ + ib * MB) * DM + h * HD; r.km = kmean + (size_t)bh * NBLK * HD; r.ssa = ssa + (size_t)(b * SEQ + ib * MB) * NH + h; r.ib = ib;
    r.sl2 = __builtin_amdgcn_exp2f(-(float)(h + 1)) * LOG2E; return r;
}
struct Args { const float* in[30]; float* out; unsigned char* ws; int ph_lo, ph_hi; };
__global__ void __launch_bounds__(NWAVES * 64, 2) mk_fwd(Args args) {
    extern __shared__ __attribute__((aligned(16))) unsigned char lds_raw[];
    LAS unsigned char* lds = (LAS unsigned char*)lds_raw;
    volatile LAS unsigned* MISC = (volatile LAS unsigned*)(lds + MISC_OFF);
    const int wave = __builtin_amdgcn_readfirstlane((int)threadIdx.x >> 6);
#define PH_TID const int tid = opaque_tid(), lane = tid & 63; (void)lane; (void)tid
    const int G = gridDim.x, bx = blockIdx.x, vcu = (G % 8 == 0) ? (bx % 8) * (G / 8) + bx / 8 : bx;
    const int gw = vcu * NWAVES + wave, NGW = G * NWAVES;
    unsigned char* ws = args.ws;
    float* ctlf = (float*)(ws + WS_CTL); gu32* ctl = (gu32*)(ws + WS_CTL);
    float* mod = ctlf + CW_MOD; float* kmean = ctlf + CW_KMEAN;
    float *st1 = (float*)(ws + WS_RSTAT), *st2 = st1 + 2 * MTOK, *ssa8 = (float*)(ws + WS_SSP), *sss16 = (float*)(ws + WS_SSP + SSP_SSS);
    bf16 *Wgu1 = (bf16*)(ws + WS_WGU1), *Wd1 = (bf16*)(ws + WS_WD1), *Win = (bf16*)(ws + WS_WIN), *Wglu = (bf16*)(ws + WS_WGLU), *Wout = (bf16*)(ws + WS_WOUT), *Wgu2 = (bf16*)(ws + WS_WGU2), *Wd2 = (bf16*)(ws + WS_WD2);
    bf16 *A = (bf16*)(ws + WS_A), *H = (bf16*)(ws + WS_H), *QKVU = (bf16*)(ws + WS_QKVU), *Yact = (bf16*)(ws + WS_YACT);
    float *sA1 = (float*)(ws + WS_RSTAT + RS_SA), *sA2 = sA1 + MTOK, *sW1 = (float*)(ws + WS_RSTAT + RS_SW), *sW2 = sW1 + 2 * FF;
    bf16* R = (bf16*)(ws + WS_R);
    const float* x = args.in[0];
    for (int u = threadIdx.x; u < (LDS_BYTES - LDSCTL_OFF) / 4; u += NWAVES * 64) ((LAS unsigned*)(lds + LDSCTL_OFF))[u] = 0u;
    __syncthreads();
    if ((threadIdx.x & 63) == 0) lds[WAVETAB_LDS + ((unsigned)__builtin_amdgcn_s_getreg(((6 - 1) << 11) | (0 << 6) | 4) & 63u)] = (unsigned char)(threadIdx.x >> 6);
    __syncthreads();
    XcdBarrier bar; bar.bar = (unsigned*)(ctl + CW_BAR); bar.x = 0; bar.st = nullptr;
    if (!MK_PER_PHASE) bar = xcd_barrier_post((unsigned*)(ctl + CW_BAR), MISC + 8);
    const int lo = args.ph_lo, hi = args.ph_hi;
#define IN(k) (lo <= (k) && (k) < hi)
#ifndef PROBE_MASK
#define PROBE_MASK 0
#endif
#define NREP(k) (((PROBE_MASK >> (k)) & 1) ? 2 : 1)
#define PHASE(k) for (int rep = 0; rep < NREP(k); ++rep) if (IN(k))
#define UMUL(bit) (((PROBE_MASK >> (bit)) & 1) ? 2 : 1)
#define SHD(p, k) ((NREP(k) == 2 && rep == 0) ? (p) + CW_SHADOW : (p))
#define SEAM(k) do { if (IN(k) && IN((k) + 1)) { xcd_barrier(bar); if ((PROBE_MASK >> 16) & 1) xcd_barrier(bar); } } while (0)

    PHASE(0) {
        PH_TID;
        LAS float* scr = (LAS float*)(lds + wave * 8704);
        LAS float* sc = (LAS float*)(lds + 73728);
        for (int i = tid; i < NB * DM; i += NWAVES * 64) { const float cv = args.in[1][i]; sc[i] = cv * fsigm(cv); }
        __syncthreads();
        {
            const float* wada = args.in[2]; LAS float* part = (LAS float*)(lds + 106496);
            typedef float f32x2 __attribute__((ext_vector_type(2)));
            for (int cg = vcu; cg < NMOD * DM / 128; cg += G) {
                const int col = cg * 128 + 2 * lane, k0 = wave * (DM / NWAVES);
                f32x2 a0 = {0.f, 0.f}, a1 = a0, a2 = a0, a3 = a0;
#pragma unroll 16
                for (int k = k0; k < k0 + DM / NWAVES; ++k) { const f32x2 w = *(const GAS f32x2*)(wada + (size_t)k * (NMOD * DM) + col);
                    a0 += w * sc[k]; a1 += w * sc[DM + k]; a2 += w * sc[2 * DM + k]; a3 += w * sc[3 * DM + k]; }
                __syncthreads();
                *(LAS f32x2*)(part + (wave * 4 + 0) * 128 + 2 * lane) = a0; *(LAS f32x2*)(part + (wave * 4 + 1) * 128 + 2 * lane) = a1;
                *(LAS f32x2*)(part + (wave * 4 + 2) * 128 + 2 * lane) = a2; *(LAS f32x2*)(part + (wave * 4 + 3) * 128 + 2 * lane) = a3;
                __syncthreads();
                { const int bb = tid >> 7, c = tid & 127; float s = args.in[3][cg * 128 + c];
#pragma unroll
                  for (int w8 = 0; w8 < NWAVES; ++w8) s += part[(w8 * 4 + bb) * 128 + c];
                  mod[(size_t)bb * NMOD * DM + cg * 128 + c] = s; }
            }
        }
        if (I8_GU) {
            unsigned* cm = (unsigned*)(ctl + CW_CMAX); constexpr int IC = (FF / 256) * (DM / 32);
            for (int it = gw; it < 4 * IC; it += NGW) { const int mt = it / IC, r = it % IC;
                p0_colmax_item(args.in[mt == 0 ? 4 : mt == 1 ? 5 : mt == 2 ? 25 : 26], FF, 1 + (mt & 1), cm + (mt >> 1) * 2 * FF, r, lane); }
            if (IN(0) && IN(1)) xcd_barrier(bar);
        }
        if (gw >= NGW - NG) s5::tables(args.in[11], args.in[12], args.in[13], args.in[14], args.in[15], args.in[16], args.in[17], ws + WS_SSMTAB, gw - (NGW - NG), lane);
        {
            constexpr int I_GU = (DM / 64) * (FF / 32), I_D = (FF / 64) * (DM / 32), I_IN = (DM / 64) * (INW / 32), I_GLU = (SW / 64) * (SW / 32), I_OUT = (DM / 64) * (DM / 32);
            constexpr int NITEMS = 4 * I_GU + 2 * I_D + I_IN + I_GLU + I_OUT;
            for (int it = gw; it < NITEMS; it += NGW) {
                int r = it;
                if (r < I_GU) { if (I8_GU1) p0_transpose_item_i8(args.in[4], DM, FF, (signed char*)Wgu1, 1, (const unsigned*)(ctl + CW_CMAX), sW1, scr, r, lane); else p0_transpose_item(args.in[4], DM, FF, Wgu1, 1, nullptr, scr, r, lane); continue; } r -= I_GU;
                if (r < I_GU) { if (I8_GU1) p0_transpose_item_i8(args.in[5], DM, FF, (signed char*)Wgu1, 2, (const unsigned*)(ctl + CW_CMAX), sW1, scr, r, lane); else p0_transpose_item(args.in[5], DM, FF, Wgu1, 2, nullptr, scr, r, lane); continue; } r -= I_GU;
                if (r < I_GU) { if (I8_GU2) p0_transpose_item_i8(args.in[25], DM, FF, (signed char*)Wgu2, 1, (const unsigned*)(ctl + CW_CMAX) + 2 * FF, sW2, scr, r, lane); else p0_transpose_item(args.in[25], DM, FF, Wgu2, 1, nullptr, scr, r, lane); continue; } r -= I_GU;
                if (r < I_GU) { if (I8_GU2) p0_transpose_item_i8(args.in[26], DM, FF, (signed char*)Wgu2, 2, (const unsigned*)(ctl + CW_CMAX) + 2 * FF, sW2, scr, r, lane); else p0_transpose_item(args.in[26], DM, FF, Wgu2, 2, nullptr, scr, r, lane); continue; } r -= I_GU;
                if (r < I_D) { if (F8_DOWN1) p0_transpose_item8(args.in[6], FF, DM, (unsigned char*)Wd1, 128.f, scr, r, lane); else p0_transpose_item(args.in[6], FF, DM, Wd1, 0, nullptr, scr, r, lane); continue; } r -= I_D;
                if (r < I_D) { if (F8_DOWN2) p0_transpose_item8(args.in[27], FF, DM, (unsigned char*)Wd2, 128.f, scr, r, lane); else p0_transpose_item(args.in[27], FF, DM, Wd2, 0, nullptr, scr, r, lane); continue; } r -= I_D;
                if (r < I_GLU) { p0_transpose_item(args.in[19], SW, SW, Wglu, 0, nullptr, scr, r, lane); continue; } r -= I_GLU;
                if (r < I_OUT) { const int kb = r / (DM / 32); const float* ks = (kb < AW / 64) ? args.in[10] : (args.in[21] - AW);
                    p0_transpose_item(args.in[22], DM, DM, Wout, 0, ks, scr, r, lane); continue; } r -= I_OUT;
                p0_transpose_item(args.in[9], DM, INW, Win, 0, nullptr, scr, r, lane);
            }
        }
    }
    SEAM(0);
    PHASE(1) { PH_TID; if (I8_GU1) row_phase<false, 2, false>(x, nullptr, nullptr, nullptr, mod, 0, A, nullptr, sA1, R, gw, NGW, lane);
        else row_phase<false, 1, false>(x, nullptr, nullptr, nullptr, mod, 0, A, nullptr, nullptr, nullptr, gw, NGW, lane); }
    SEAM(1);
    PHASE(2) { pg8::Gemm g{A, Wgu1, MTOK, 2 * FF, I8_GU1 ? DM / 2 : DM}; pg8::StaticOrder S; S.init(MTOK, 2 * FF, G, bx); S.mul = UMUL(17);
        if constexpr (I8_GU1 != 0) { pg8::EpiSwigluI8<F8_DOWN1 != 0> E{H, sA1, sW1}; pg8::gemm_phase<pg8::EpiSwigluI8<F8_DOWN1 != 0>, pg8::StaticOrder, true, true, -1>(lds + RING_OFF, g, S, E); }
        else { pg8::EpiSwiglu<F8_DOWN1 != 0> E{H}; pg8::gemm_phase<pg8::EpiSwiglu<F8_DOWN1 != 0>, pg8::StaticOrder, true, true>(lds + RING_OFF, g, S, E); } }
    SEAM(2);
    PHASE(3) { pg8::Gemm g{H, Wd1, MTOK, DM, F8_DOWN1 ? FF / 2 : FF}; pg8::StaticOrder S; S.init(MTOK, DM, G, bx);
        S.mul = UMUL(18); pg8::EpiResid<false, true> E{nullptr, I8_GU1 ? R : A, R, R, UMUL(18), nullptr, nullptr, nullptr, mod + 2 * DM, nullptr, I8_GU1 ? nullptr : mod};
        pg8::gemm_phase<pg8::EpiResid<false, true>, pg8::StaticOrder, true, true, F8_DOWN1 ? 118 : 0>(lds + RING_OFF, g, S, E); }
    SEAM(3);
    PHASE(4) { PH_TID; row_phase<true, 1, true>(R, st1, args.in[7], args.in[8], mod, 3, A, nullptr, nullptr, nullptr, gw, NGW, lane); }
    SEAM(4);
    PHASE(5) { pg8::Gemm g{A, Win, MTOK, INW, DM}; pg8::StaticOrder S; S.init(MTOK, INW, G, bx); S.mul = UMUL(19); pg8::EpiQKVU E{QKVU, SHD(kmean, 5)};
        pg8::gemm_phase<pg8::EpiQKVU, pg8::StaticOrder, true, true>(lds + RING_OFF, g, S, E); }
    SEAM(5);
    PHASE(6) {
        for (int r13 = 0; r13 < NREP(13); ++r13)
        for (int un = vcu; un < NB * NG; un += G) s5::unit(QKVU, ws + WS_SSMTAB, args.in[18], Yact, un / NG, un % NG, lds);
        for (int r14 = 0; r14 < NREP(14); ++r14) {
        char* alds = (char*)lds_raw; moba::Seam S; bool first = true;
        for (int pi = vcu; pi < NB * NH * 8; pi += G) {
            const moba::BlockRef u0 = attn_ref(QKVU, A, kmean, ssa8, pi, 0), u1 = attn_ref(QKVU, A, kmean, ssa8, pi, 1);
            const moba::BlockRef nx = (pi + G < NB * NH * 8) ? attn_ref(QKVU, A, kmean, ssa8, pi + G, 0) : u1;
            if (first) { moba::prime(u0, alds, S); first = false; }
            moba::block(u0, u1, alds, S); moba::block(u1, nx, alds, S);
        }
        __syncthreads();
        }
    }
    SEAM(6);
    PHASE(7) { pg8::Gemm g{Yact, Wglu, MTOK, SW, SW}; pg8::StaticOrder S; S.init(MTOK, SW, G, bx); S.mul = UMUL(20); pg8::EpiGlu E{Yact, args.in[20], A, sss16};
        pg8::gemm_phase<pg8::EpiGlu, pg8::StaticOrder, true, true>(lds + RING_OFF, g, S, E); }
    SEAM(7);
    PHASE(8) { PH_TID; pg8::Gemm g{A, Wout, MTOK, DM, DM}; pg8::StaticOrder S; S.init(MTOK, DM, G, bx);
        LAS float* fac = (LAS float*)(lds + FAC_OFF);
        for (int i = 0; i < 2; ++i) { pg8::Unit u; if (S.next(i, u) && tid < 256) { const int row = u.pm * 256 + tid;
            const f32x4 a0 = *(const f32x4*)(ssa8 + (size_t)row * 8), a1 = *(const f32x4*)(ssa8 + (size_t)row * 8 + 4);
            const float sa = ((a0[0] + a0[1]) + (a0[2] + a0[3])) + ((a1[0] + a1[1]) + (a1[2] + a1[3])); float sz = 0.f;
#pragma unroll
            for (int k = 0; k < 4; ++k) { const f32x4 z4 = *(const f32x4*)(sss16 + (size_t)row * 16 + 4 * k); sz += (z4[0] + z4[1]) + (z4[2] + z4[3]); }
            const float rsa = rsqrtf(sa * (1.f / AW) + LN_EPS), rss = rsqrtf(sz * (1.f / SW) + LN_EPS);
            fac[i * 256 + tid] = rsa / rss; fac[(2 + i) * 256 + tid] = rss; } }
        __syncthreads();
        S.mul = UMUL(21); pg8::EpiResid<true, false> E{nullptr, R, (NREP(8) == 2 && rep == 0) ? (bf16*)args.out : R, (bf16*)args.out, UMUL(21), st1, args.in[7], args.in[8], mod + 5 * DM, fac, nullptr};
        pg8::gemm_phase<pg8::EpiResid<true, false>, pg8::StaticOrder, true, true>(lds + RING_OFF, g, S, E); }
    SEAM(8);
    PHASE(9) { PH_TID; if (I8_GU2) row_phase<true, 2, true>(R, st2, args.in[23], args.in[24], mod, 6, A, nullptr, sA2, nullptr, gw, NGW, lane);
        else row_phase<true, 1, true>(R, st2, args.in[23], args.in[24], mod, 6, A, nullptr, nullptr, nullptr, gw, NGW, lane); }
    SEAM(9);
    PHASE(10) { pg8::Gemm g{A, Wgu2, MTOK, 2 * FF, I8_GU2 ? DM / 2 : DM}; pg8::StaticOrder S; S.init(MTOK, 2 * FF, G, bx); S.mul = UMUL(22);
        if constexpr (I8_GU2 != 0) { pg8::EpiSwigluI8<F8_DOWN2 != 0> E{H, sA2, sW2}; pg8::gemm_phase<pg8::EpiSwigluI8<F8_DOWN2 != 0>, pg8::StaticOrder, true, true, -1>(lds + RING_OFF, g, S, E); }
        else { pg8::EpiSwiglu<F8_DOWN2 != 0> E{H}; pg8::gemm_phase<pg8::EpiSwiglu<F8_DOWN2 != 0>, pg8::StaticOrder, true, true>(lds + RING_OFF, g, S, E); } }
    SEAM(10);
    PHASE(11) { pg8::Gemm g{H, Wd2, MTOK, DM, F8_DOWN2 ? FF / 2 : FF}; pg8::StaticOrder S; S.init(MTOK, DM, G, bx);
        S.mul = UMUL(23); pg8::EpiResid<false, true> E{nullptr, R, (NREP(11) == 2 && rep == 0) ? (bf16*)args.out : R, (bf16*)args.out, UMUL(23), st2, args.in[23], args.in[24], mod + 8 * DM, nullptr, nullptr};
        pg8::gemm_phase<pg8::EpiResid<false, true>, pg8::StaticOrder, true, true, F8_DOWN2 ? 118 : 0>(lds + RING_OFF, g, S, E); }
    SEAM(11);
    PHASE(12) { PH_TID; row_phase<true, 0, true>(R, nullptr, args.in[28], args.in[29], mod, 0, nullptr, args.out, nullptr, nullptr, gw, NGW, lane); }
#undef IN
#undef SEAM
}

extern "C" void kernel_launch(void* const* d_in, const int* in_sizes, int n_in, void* d_out, int out_size, void* d_ws, size_t ws_size, hipStream_t stream) {
    static int grid = 0;
    if (grid == 0) {
        if (n_in != 30 || out_size != MTOK * DM || ws_size < WS_END) { fprintf(stderr, "kernel_launch: unexpected problem (n_in %d out %d ws %zu)\n", n_in, out_size, ws_size); grid = -1; return; }
        int dev = 0, cus = 0, per_cu = 0;
        if (hipGetDevice(&dev) != hipSuccess || hipDeviceGetAttribute(&cus, hipDeviceAttributeMultiprocessorCount, dev) != hipSuccess) { grid = -1; return; }
        if (hipFuncSetAttribute((const void*)mk_fwd, hipFuncAttributeMaxDynamicSharedMemorySize, LDS_BYTES) != hipSuccess) { fprintf(stderr, "kernel_launch: hipFuncSetAttribute failed\n"); grid = -1; return; }
        if (hipOccupancyMaxActiveBlocksPerMultiprocessor(&per_cu, (const void*)mk_fwd, NWAVES * 64, LDS_BYTES) != hipSuccess || per_cu < 1) { fprintf(stderr, "kernel_launch: occupancy query reports %d\n", per_cu); }
        (void)hipGetLastError();
        grid = cus;
    }
    if (grid < 0) return;
    if (hipMemsetAsync((char*)d_ws + WS_CTL, 0, CTL_BYTES, stream) != hipSuccess) return;
    Args a{};
    for (int i = 0; i < 30; ++i) a.in[i] = (const float*)d_in[i];
    a.out = (float*)d_out; a.ws = (unsigned char*)d_ws;
#if MK_PER_PHASE
    for (int p = 0; p < N_PHASES; ++p) { a.ph_lo = p; a.ph_hi = p + 1; hipLaunchKernelGGL(mk_fwd, dim3(grid), dim3(NWAVES * 64), LDS_BYTES, stream, a); }
#else
    a.ph_lo = 0; a.ph_hi = N_PHASES;
    hipLaunchKernelGGL(mk_fwd, dim3(grid), dim3(NWAVES * 64), LDS_BYTES, stream, a);
#endif
}
```
